# Optimizing an MI355X kernel written in HIP

```python
import math
import jax, jax.numpy as jnp
from jax import lax
import numpy as np

D_MODEL = 4096
BATCH = 1
SEQ = 8192
DEPTH = 1

NH_M = 4
DQK_M = 256
DV_M = 512
CONV_W = 4
NH_R = 4
DQK_R = 256
DV_R = 512
D_FF = 11008
CHUNK = 128
ROPE_BASE = 10000.0
LN_EPS = 1e-5
HEAD_EPS = 1e-6
ALPHA = (2.0 * DEPTH) ** 0.25
BETA = (8.0 * DEPTH) ** -0.25

WM_QK = NH_M * DQK_M
WM_V = NH_M * DV_M
WR_QK = NH_R * DQK_R
WR_V = NH_R * DV_R
D_IN = 2 * WM_QK + 2 * WM_V + 2 * NH_M + 2 * WR_QK + 2 * WR_V + 2 * D_MODEL

kernel_name = 'hybrid_mlstm_retention_macaron_deepnorm'


def layer_norm(x, w, b):
    xf = x.astype(jnp.float32)
    mu = xf.mean(-1, keepdims=True)
    var = jnp.square(xf - mu).mean(-1, keepdims=True)
    return ((xf - mu) * lax.rsqrt(var + LN_EPS) * w + b).astype(x.dtype)


def head_norm(h, w):
    B, S, H, Dh = h.shape
    hf = h.astype(jnp.float32)
    mu = hf.mean(-1, keepdims=True)
    var = jnp.square(hf - mu).mean(-1, keepdims=True)
    out = (hf - mu) * lax.rsqrt(var + HEAD_EPS) * w.reshape(H, Dh)
    return out.reshape(B, S, H * Dh)


def swiglu(x, w_gate, w_up, w_down):
    return (jax.nn.silu(x @ w_gate) * (x @ w_up)) @ w_down


def causal_dwconv(x, w, b):
    C = x.shape[-1]
    out = lax.conv_general_dilated(x, w[:, None, :].astype(x.dtype), window_strides=(1,),
                                   padding=((CONV_W - 1, 0),),
                                   dimension_numbers=('NWC', 'WIO', 'NWC'),
                                   feature_group_count=C)
    return out + b


def rope(x, positions):
    Dh = x.shape[-1]
    inv = ROPE_BASE ** (-jnp.arange(0, Dh, 2, dtype=jnp.float32) / Dh)
    ang = positions.astype(jnp.float32)[..., None] * inv
    cos = jnp.cos(ang)[:, :, None, :]
    sin = jnp.sin(ang)[:, :, None, :]
    x1, x2 = x[..., :Dh // 2], x[..., Dh // 2:]
    return jnp.concatenate([x1 * cos - x2 * sin, x2 * cos + x1 * sin], axis=-1)


def to_chunks(x):
    B, S, H, D = x.shape
    return x.reshape(B, S // CHUNK, CHUNK, H, D).transpose(1, 0, 3, 2, 4)


def from_chunks(y):
    N, B, H, L, D = y.shape
    return y.transpose(1, 0, 3, 2, 4).reshape(B, N * L, H, D)


def gate_chunks(g):
    B, S, H = g.shape
    return g.reshape(B, S // CHUNK, CHUNK, H).transpose(1, 0, 3, 2)


def mlstm_chunkwise(q, k, v, i_pre, f_pre):
    B, S, H, DK = q.shape
    DV = v.shape[-1]
    qc = to_chunks(q.astype(jnp.float32)) * (DK ** -0.5)
    kc = to_chunks(k.astype(jnp.float32))
    vc = to_chunks(v.astype(jnp.float32))
    ic = gate_chunks(i_pre.astype(jnp.float32))
    lfc = gate_chunks(jax.nn.log_sigmoid(f_pre.astype(jnp.float32)))
    causal = jnp.tril(jnp.ones((CHUNK, CHUNK), dtype=bool))

    def step(carry, inp):
        C, n, m = carry
        qb, kb, vb, ib, lfb = inp
        b = jnp.cumsum(lfb, axis=-1)
        D = b[..., :, None] - b[..., None, :] + ib[..., None, :]
        D = jnp.where(causal, D, -jnp.inf)
        inter = b + m[..., None]
        m_t = jnp.maximum(inter, D.max(-1))
        w_intra = jnp.exp(D - m_t[..., None])
        w_inter = jnp.exp(inter - m_t)
        s = jnp.einsum('bhld,bhsd->bhls', qb, kb) * w_intra
        num = jnp.einsum('bhls,bhsv->bhlv', s, vb) + w_inter[..., None] * jnp.einsum('bhld,bhdv->bhlv', qb, C)
        den = s.sum(-1) + w_inter * jnp.einsum('bhld,bhd->bhl', qb, n)
        h = num / jnp.maximum(jnp.abs(den), jnp.exp(-m_t))[..., None]
        m_new = m_t[..., -1]
        w_k = jnp.exp(b[..., -1:] - b + ib - m_new[..., None])
        decay = jnp.exp(b[..., -1] + m - m_new)
        C_new = decay[..., None, None] * C + jnp.einsum('bhsd,bhsv->bhdv', kb * w_k[..., None], vb)
        n_new = decay[..., None] * n + jnp.einsum('bhsd,bhs->bhd', kb, w_k)
        return (C_new, n_new, m_new), h

    init = (jnp.zeros((B, H, DK, DV), jnp.float32),
            jnp.zeros((B, H, DK), jnp.float32),
            jnp.zeros((B, H), jnp.float32))
    _, hs = lax.scan(step, init, (qc, kc, vc, ic, lfc))
    return from_chunks(hs)


def retention_chunkwise(q, k, v):
    B, S, H, DK = q.shape
    DV = v.shape[-1]
    log_g = jnp.log(1.0 - 2.0 ** (-5.0 - jnp.arange(H, dtype=jnp.float32)))
    pos = jnp.arange(CHUNK, dtype=jnp.float32)
    diff = pos[:, None] - pos[None, :]
    decay_mask = jnp.where(diff >= 0, jnp.exp(log_g[:, None, None] * jnp.maximum(diff, 0.0)), 0.0)
    q_decay = jnp.exp(log_g[:, None] * (pos + 1.0))
    k_decay = jnp.exp(log_g[:, None] * (CHUNK - 1.0 - pos))
    chunk_decay = jnp.exp(log_g * CHUNK)
    qc = to_chunks(q.astype(jnp.float32))
    kc = to_chunks(k.astype(jnp.float32)) * (DK ** -0.5)
    vc = to_chunks(v.astype(jnp.float32))

    def step(R, inp):
        qb, kb, vb = inp
        s = jnp.einsum('bhld,bhsd->bhls', qb, kb) * decay_mask
        intra = jnp.einsum('bhls,bhsv->bhlv', s, vb)
        inter = jnp.einsum('bhld,bhdv->bhlv', qb * q_decay[..., None], R)
        R_new = chunk_decay[:, None, None] * R + jnp.einsum('bhsd,bhsv->bhdv', kb * k_decay[..., None], vb)
        return R_new, intra + inter

    _, ys = lax.scan(step, jnp.zeros((B, H, DK, DV), jnp.float32), (qc, kc, vc))
    return from_chunks(ys)


def token_mixer(x, positions, w_in, if_bias, conv_w, conv_b, norm_m_w, norm_r_w, w_proj_m, w_proj_r, w_out):
    B, S, _ = x.shape
    proj = x @ w_in
    sizes = (WM_QK, WM_QK, WM_V, WM_V, 2 * NH_M, WR_QK, WR_QK, WR_V, WR_V, D_MODEL, D_MODEL)
    cuts = tuple(int(c) for c in np.cumsum(sizes)[:-1])
    q_m, k_m, v_m, o_m, if_m, q_r, k_r, v_r, g_r, gate_a, gate_b = jnp.split(proj, cuts, axis=-1)

    qk_m = jax.nn.silu(causal_dwconv(jnp.concatenate([q_m, k_m], axis=-1), conv_w, conv_b))
    q_m, k_m = qk_m[..., :WM_QK], qk_m[..., WM_QK:]
    gates = if_m.astype(jnp.float32) + if_bias
    h_m = mlstm_chunkwise(q_m.reshape(B, S, NH_M, DQK_M), k_m.reshape(B, S, NH_M, DQK_M),
                          v_m.reshape(B, S, NH_M, DV_M), gates[..., :NH_M], gates[..., NH_M:])
    y_m = (head_norm(h_m, norm_m_w) * jax.nn.sigmoid(o_m.astype(jnp.float32))).astype(x.dtype)

    q_r = rope(q_r.reshape(B, S, NH_R, DQK_R), positions)
    k_r = rope(k_r.reshape(B, S, NH_R, DQK_R), positions)
    h_r = retention_chunkwise(q_r, k_r, v_r.reshape(B, S, NH_R, DV_R))
    y_r = (head_norm(h_r, norm_r_w) * jax.nn.silu(g_r.astype(jnp.float32))).astype(x.dtype)

    merged = jax.nn.sigmoid(gate_a) * (y_m @ w_proj_m) + jax.nn.sigmoid(gate_b) * (y_r @ w_proj_r)
    return merged @ w_out


def setup_inputs(seed: int = 0) -> dict:
    key = jax.random.key(seed)
    ks = jax.random.split(key, 24)
    f32 = jnp.float32
    nrm = lambda k, shape, scale: jax.random.normal(k, shape, f32) * scale
    L = DEPTH
    f_bias = jnp.linspace(3.0, 6.0, NH_M, dtype=f32)[None, :] + nrm(ks[9], (L, NH_M), 0.1)
    i_bias = nrm(ks[8], (L, NH_M), 0.1)
    return {
        'x': nrm(ks[0], (BATCH, SEQ, D_MODEL), 1.0),
        'positions': jnp.broadcast_to(jnp.arange(SEQ, dtype=jnp.int32), (BATCH, SEQ)),
        'ffn1_w_gate': nrm(ks[1], (L, D_MODEL, D_FF), D_MODEL ** -0.5),
        'ffn1_w_up': nrm(ks[2], (L, D_MODEL, D_FF), D_MODEL ** -0.5),
        'ffn1_w_down': nrm(ks[3], (L, D_FF, D_MODEL), BETA * D_FF ** -0.5),
        'ln1_w': 1.0 + nrm(ks[4], (L, D_MODEL), 0.02),
        'ln1_b': nrm(ks[5], (L, D_MODEL), 0.02),
        'w_in': nrm(ks[6], (L, D_MODEL, D_IN), D_MODEL ** -0.5),
        'if_bias': jnp.concatenate([i_bias, f_bias], axis=-1),
        'conv_w': nrm(ks[7], (L, CONV_W, 2 * WM_QK), CONV_W ** -0.5),
        'conv_b': nrm(ks[10], (L, 2 * WM_QK), 0.02),
        'norm_m_w': 1.0 + nrm(ks[11], (L, WM_V), 0.02),
        'norm_r_w': 1.0 + nrm(ks[12], (L, WR_V), 0.02),
        'w_proj_m': nrm(ks[13], (L, WM_V, D_MODEL), BETA * WM_V ** -0.5),
        'w_proj_r': nrm(ks[14], (L, WR_V, D_MODEL), BETA * WR_V ** -0.5),
        'w_out': nrm(ks[15], (L, D_MODEL, D_MODEL), BETA * D_MODEL ** -0.5),
        'ln2_w': 1.0 + nrm(ks[16], (L, D_MODEL), 0.02),
        'ln2_b': nrm(ks[17], (L, D_MODEL), 0.02),
        'ffn2_w_gate': nrm(ks[18], (L, D_MODEL, D_FF), D_MODEL ** -0.5),
        'ffn2_w_up': nrm(ks[19], (L, D_MODEL, D_FF), D_MODEL ** -0.5),
        'ffn2_w_down': nrm(ks[20], (L, D_FF, D_MODEL), BETA * D_FF ** -0.5),
        'ln3_w': 1.0 + nrm(ks[21], (L, D_MODEL), 0.02),
        'ln3_b': nrm(ks[22], (L, D_MODEL), 0.02),
    }


def reference(x, positions, ffn1_w_gate, ffn1_w_up, ffn1_w_down, ln1_w, ln1_b, w_in, if_bias, conv_w, conv_b,
              norm_m_w, norm_r_w, w_proj_m, w_proj_r, w_out, ln2_w, ln2_b, ffn2_w_gate, ffn2_w_up, ffn2_w_down,
              ln3_w, ln3_b):
    h = x
    for l in range(DEPTH):
        h = layer_norm(ALPHA * h + 0.5 * swiglu(h, ffn1_w_gate[l], ffn1_w_up[l], ffn1_w_down[l]), ln1_w[l], ln1_b[l])
        mix = token_mixer(h, positions, w_in[l], if_bias[l], conv_w[l], conv_b[l], norm_m_w[l], norm_r_w[l],
                          w_proj_m[l], w_proj_r[l], w_out[l])
        h = layer_norm(ALPHA * h + mix, ln2_w[l], ln2_b[l])
        h = layer_norm(ALPHA * h + 0.5 * swiglu(h, ffn2_w_gate[l], ffn2_w_up[l], ffn2_w_down[l]), ln3_w[l], ln3_b[l])
    return h
```

```cpp
#include <hip/hip_runtime.h>
#include <cstdio>
#include <cstdint>
namespace pg8 {
#define PG8_LAS __attribute__((address_space(3)))
typedef unsigned short bf16_t;
typedef short bf16x8 __attribute__((ext_vector_type(8)));
typedef float f32x4 __attribute__((ext_vector_type(4)));
typedef unsigned u32x4 __attribute__((ext_vector_type(4)));
typedef int v4i32 __attribute__((ext_vector_type(4)));
typedef int v8i32 __attribute__((ext_vector_type(8)));
constexpr int BM = 256, BK = 64, HALF = 128, HTB = HALF * BK * 2  , STAGE_BYTES = 8 * HTB, NXCD = 8, WGM = 8;

__host__ __device__ __forceinline__ int lds_byte(int r, int c) { const int st = (r >> 4) * 2 + (c >> 5), rr = r & 15, cc = c & 31, ob = rr * 64 + cc * 2; return st * 1024 + (ob ^ (((ob >> 9) & 1) << 5)); }
__host__ __device__ __forceinline__ void stage_rc(int b, int& R, int& C) { const int st = b / 1024, sb = b % 1024, swz = sb ^ (((sb >> 9) & 1) << 5); R = (st >> 1) * 16 + swz / 64; C = (st & 1) * 32 + (swz % 64) / 2; }
__host__ __device__ __forceinline__ int perm32(int rho) { const int n = rho >> 4, i = rho & 15; return 8 * (i >> 2) + 4 * n + (i & 3); }

struct Unit { int pm, pn; };
struct Gemm { const bf16_t* A; const bf16_t* Bt; int M, N, K; };

struct StaticOrder {
    int nM, nN, nwg, G, c;
    __host__ __device__ void init(int M, int N, int G_, int c_) { nM = M / BM; nN = N / BM; nwg = nM * nN; G = G_; c = c_; }
    __host__ __device__ bool next(int i, Unit& u) const {
        const long L = (long)i * G + c; if (L >= nwg) return false;
        int wgid = (int)L; { const int q = nwg / NXCD, r = nwg % NXCD, xcd = wgid % NXCD, off = wgid / NXCD; wgid = (xcd < r ? xcd * (q + 1) : r * (q + 1) + (xcd - r) * q) + off; }
        const int nig = WGM * nN, gid = wgid / nig, fm = gid * WGM, gsz = (nM - fm) < WGM ? (nM - fm) : WGM;
        u.pm = fm + ((wgid % nig) % gsz); u.pn = (wgid % nig) / gsz; return true;
    }
    __device__ __forceinline__ void a_ready(const Unit&) const {}
    __device__ __forceinline__ void done(const Unit&) const {}
};
typedef float f32x2c __attribute__((ext_vector_type(2)));
typedef __bf16 bf16x2c __attribute__((ext_vector_type(2)));
__device__ __forceinline__ unsigned cvt_pk_bf16(float lo, float hi) { const f32x2c v = {lo, hi}; const bf16x2c r = __builtin_convertvector(v, bf16x2c); return __builtin_bit_cast(unsigned, r); }
typedef float f32x2 __attribute__((ext_vector_type(2)));
__device__ __forceinline__ float fast_sigmoid(float x) { return __builtin_amdgcn_rcpf(1.0f + __builtin_amdgcn_exp2f(-1.4426950408889634f * x)); }
__device__ __forceinline__ float bf_lo(unsigned w) { return __uint_as_float(w << 16); }
__device__ __forceinline__ float bf_hi(unsigned w) { return __uint_as_float(w & 0xffff0000u); }

struct EpiPlainBf16 {
    static constexpr bool PERM = true, AFTER_DRAIN = false;
    bf16_t* O; int ldc;
    __device__ __forceinline__ void operator()(const f32x4 (&acc)[2][2][4][2], const Unit& u, int wr, int wc, int fr, int fq) const {
        const int row0 = u.pm * BM + wr * 64 + fr; const int col0 = u.pn * BM + wc * 32 + 8 * fq;
#pragma unroll
        for (int ai = 0; ai < 2; ++ai)
#pragma unroll
            for (int m = 0; m < 4; ++m) { bf16_t* rowp = O + (size_t)(row0 + ai * HALF + m * 16) * ldc + col0;
#pragma unroll
                for (int bj = 0; bj < 2; ++bj) { const f32x4 v0 = acc[ai][bj][m][0], v1 = acc[ai][bj][m][1];
                    u32x4 w; w.x = cvt_pk_bf16(v0[0], v0[1]); w.y = cvt_pk_bf16(v0[2], v0[3]); w.z = cvt_pk_bf16(v1[0], v1[1]); w.w = cvt_pk_bf16(v1[2], v1[3]);
                    *(u32x4*)(rowp + bj * HALF) = w; } }
    }
};
struct EpiSwiGLU {
    static constexpr bool PERM = true, AFTER_DRAIN = false;
    bf16_t* H; int ldh;
    __device__ __forceinline__ void operator()(const f32x4 (&acc)[2][2][4][2], const Unit& u, int wr, int wc, int fr, int fq) const {
        const int row0 = u.pm * BM + wr * 64 + fr; const int col0 = u.pn * HALF + wc * 32 + 8 * fq;
#pragma unroll
        for (int ai = 0; ai < 2; ++ai)
#pragma unroll
            for (int m = 0; m < 4; ++m) { bf16_t* rowp = H + (size_t)(row0 + ai * HALF + m * 16) * ldh + col0;
                float o[8];
#pragma unroll
                for (int n = 0; n < 2; ++n)
#pragma unroll
                    for (int j = 0; j < 4; ++j) { const float g = acc[ai][0][m][n][j], up = acc[ai][1][m][n][j]; o[4 * n + j] = g * fast_sigmoid(g) * up; }
                u32x4 w; w.x = cvt_pk_bf16(o[0], o[1]); w.y = cvt_pk_bf16(o[2], o[3]); w.z = cvt_pk_bf16(o[4], o[5]); w.w = cvt_pk_bf16(o[6], o[7]);
                *(u32x4*)rowp = w; }
    }
};
struct EpiResid {
    static constexpr bool PERM = false, AFTER_DRAIN = false;
    const float* base; float* T; int ldc; float alpha, s; float* part;
    __device__ __forceinline__ void operator()(const f32x4 (&acc)[2][2][4][2], const Unit& u, int wr, int wc, int fr, int fq) const {
        const int row0 = u.pm * BM + wr * 64 + fr, col0 = u.pn * BM + wc * 32 + 4 * fq;
#pragma unroll
        for (int ai = 0; ai < 2; ++ai)
#pragma unroll
            for (int m = 0; m < 4; ++m) { const int row = row0 + ai * HALF + m * 16; const size_t off = (size_t)row * ldc + col0; float ps = 0.f, pq = 0.f;
#pragma unroll
                for (int bj = 0; bj < 2; ++bj)
#pragma unroll
                    for (int n = 0; n < 2; ++n) { const f32x4 b = *(const f32x4*)(base + off + bj * HALF + n * 16); const f32x4 o = b * alpha + acc[ai][bj][m][n] * s; *(f32x4*)(T + off + bj * HALF + n * 16) = o;
                        ps += (o[0] + o[1]) + (o[2] + o[3]); pq += (o[0] * o[0] + o[1] * o[1]) + (o[2] * o[2] + o[3] * o[3]); }
                ps += __shfl_xor(ps, 16); ps += __shfl_xor(ps, 32); pq += __shfl_xor(pq, 16); pq += __shfl_xor(pq, 32);
                if (fq == 0) { f32x2 pv; pv.x = ps; pv.y = pq; *(f32x2*)(part + ((size_t)row * 64 + u.pn * 4 + wc) * 2) = pv; } }
    }
};
template <size_t TIN_OFF, size_t TOUT_OFF, size_t STATS_OFF, size_t PART_OFF> struct EpiResidLN {
    static constexpr bool PERM = false, AFTER_DRAIN = false;
    unsigned char* ws; const float* lw; const float* lb; float s;
    __device__ __forceinline__ void operator()(const f32x4 (&acc)[2][2][4][2], const Unit& u, int, int, int, int) const {
        int tz = threadIdx.x; asm volatile("" : "+v"(tz));
        const int wid = tz >> 6, wr = wid >> 2, wc = wid & 3, fr = tz & 15, fq = (tz & 63) >> 4;
        const int row0 = u.pm * BM + wr * 64 + fr, col0 = u.pn * BM + wc * 32 + 4 * fq;
        constexpr int ldc = 4096; constexpr float alpha = 1.1892071150027210667f;
        const float* Tin = (const float*)(ws + TIN_OFF); float* Tout = (float*)(ws + TOUT_OFF); const float* stats = (const float*)(ws + STATS_OFF); float* part = (float*)(ws + PART_OFF);
        f32x4 wv[2][2], bv[2][2];
#pragma unroll
        for (int bj = 0; bj < 2; ++bj)
#pragma unroll
            for (int n = 0; n < 2; ++n) { wv[bj][n] = *(const f32x4*)(lw + col0 + bj * HALF + n * 16) * alpha; bv[bj][n] = *(const f32x4*)(lb + col0 + bj * HALF + n * 16) * alpha; }
#pragma unroll
        for (int ai = 0; ai < 2; ++ai)
#pragma unroll
            for (int m = 0; m < 4; ++m) { const int row = row0 + ai * HALF + m * 16; const size_t off = (size_t)row * ldc + col0;
                const float mean = stats[2 * row], rstd = stats[2 * row + 1]; float ps = 0.f, pq = 0.f;
#pragma unroll
                for (int bj = 0; bj < 2; ++bj)
#pragma unroll
                    for (int n = 0; n < 2; ++n) { const f32x4 t = *(const f32x4*)(Tin + off + bj * HALF + n * 16);
                        const f32x4 o = ((t - mean) * rstd) * wv[bj][n] + bv[bj][n] + acc[ai][bj][m][n] * s; *(f32x4*)(Tout + off + bj * HALF + n * 16) = o;
                        ps += (o[0] + o[1]) + (o[2] + o[3]); pq += (o[0] * o[0] + o[1] * o[1]) + (o[2] * o[2] + o[3] * o[3]); }
                ps += __shfl_xor(ps, 16); ps += __shfl_xor(ps, 32); pq += __shfl_xor(pq, 16); pq += __shfl_xor(pq, 32);
                if (fq == 0) { f32x2 pv; pv.x = ps; pv.y = pq; *(f32x2*)(part + ((size_t)row * 64 + u.pn * 4 + wc) * 2) = pv; } }
    }
};
struct EpiMerged {
    static constexpr bool PERM = true, AFTER_DRAIN = false;
    bf16_t* O; const bf16_t* ga; const bf16_t* gb; int ldg, ldc;
    __device__ __forceinline__ void mid(f32x4 (&acc)[2][2][4][2], const Unit& u, int, int, int, int) const {
        int tz = threadIdx.x; asm volatile("" : "+v"(tz));
        const int wid = tz >> 6, wr = wid >> 2, wc = wid & 3, fr = tz & 15, fq = (tz & 63) >> 4;
        const int row0 = u.pm * BM + wr * 64 + fr; const int col0 = u.pn * BM + wc * 32 + 8 * fq;
#pragma unroll
        for (int ai = 0; ai < 2; ++ai)
#pragma unroll
            for (int m = 0; m < 4; ++m) { const int row = row0 + ai * HALF + m * 16;
#pragma unroll
                for (int bj = 0; bj < 2; ++bj) { const size_t off = (size_t)row * ldg + col0 + bj * HALF;
                    const u32x4 a = *(const u32x4*)(ga + off), b = *(const u32x4*)(gb + off);
                    const unsigned aw[4] = {a.x, a.y, a.z, a.w}, bw[4] = {b.x, b.y, b.z, b.w};
#pragma unroll
                    for (int h = 0; h < 4; ++h) {
                        const float ea0 = __builtin_amdgcn_exp2f(-1.4426950408889634f * bf_lo(aw[h])), ea1 = __builtin_amdgcn_exp2f(-1.4426950408889634f * bf_hi(aw[h]));
                        const float eb0 = __builtin_amdgcn_exp2f(-1.4426950408889634f * bf_lo(bw[h])), eb1 = __builtin_amdgcn_exp2f(-1.4426950408889634f * bf_hi(bw[h]));
                        acc[ai][bj][m][h >> 1][2 * (h & 1)] *= (1.0f + eb0) * __builtin_amdgcn_rcpf(1.0f + ea0);
                        acc[ai][bj][m][h >> 1][2 * (h & 1) + 1] *= (1.0f + eb1) * __builtin_amdgcn_rcpf(1.0f + ea1); }
                }
                asm volatile("" ::: "memory"); }
    }
    __device__ __forceinline__ void operator()(const f32x4 (&acc)[2][2][4][2], const Unit& u, int, int, int, int) const {
        int tz = threadIdx.x; asm volatile("" : "+v"(tz));
        const int wid = tz >> 6, wr = wid >> 2, wc = wid & 3, fr = tz & 15, fq = (tz & 63) >> 4;
        const int row0 = u.pm * BM + wr * 64 + fr; const int col0 = u.pn * BM + wc * 32 + 8 * fq;
#pragma unroll
        for (int ai = 0; ai < 2; ++ai)
#pragma unroll
            for (int m = 0; m < 4; ++m) { const int row = row0 + ai * HALF + m * 16;
#pragma unroll
                for (int bj = 0; bj < 2; ++bj) { const int col = col0 + bj * HALF;
                    const u32x4 g = *(const u32x4*)(gb + (size_t)row * ldg + col);
                    const f32x4 v0 = acc[ai][bj][m][0], v1 = acc[ai][bj][m][1];
                    u32x4 w;
                    w.x = cvt_pk_bf16(fast_sigmoid(bf_lo(g.x)) * v0[0], fast_sigmoid(bf_hi(g.x)) * v0[1]); w.y = cvt_pk_bf16(fast_sigmoid(bf_lo(g.y)) * v0[2], fast_sigmoid(bf_hi(g.y)) * v0[3]);
                    w.z = cvt_pk_bf16(fast_sigmoid(bf_lo(g.z)) * v1[0], fast_sigmoid(bf_hi(g.z)) * v1[1]); w.w = cvt_pk_bf16(fast_sigmoid(bf_lo(g.w)) * v1[2], fast_sigmoid(bf_hi(g.w)) * v1[3]);
                    *(u32x4*)(O + (size_t)row * ldc + col) = w; } }
    }
};

template <class Epi, class Sched, bool ALIGN_EPI = false, bool SP2 = false, bool MID = false, bool FP8 = false>
__device__ __forceinline__ void gemm_phase(PG8_LAS unsigned char* lds, const Gemm g, const Sched& S, const Epi& E) {
    const int tid = threadIdx.x, wid = __builtin_amdgcn_readfirstlane(tid >> 6), lane = tid & 63, wr = wid >> 2, wc = wid & 3, fr = lane & 15, fq = lane >> 4;
    const int K = g.K, nt = K / BK;
    unsigned voffA[2], voffB[2];
#pragma unroll
    for (int i = 0; i < 2; ++i) { int R, C; stage_rc(tid * 16 + i * 8192, R, C); const int Rb = Epi::PERM ? ((R & ~31) + perm32(R & 31)) : R;
        voffA[i] = (unsigned)(R * K + C) * 2u; voffB[i] = (unsigned)(Rb * K + C) * 2u; }
    const size_t kstep = (size_t)(BK * 2);
    const size_t hstep = (size_t)HALF * K * 2;
    const size_t tstep = 2 * hstep;
    const unsigned ldsw = (unsigned)wid * 1024u;
    const int aoff = lds_byte(wr * 64 + fr, fq * 8), boff = lds_byte(wc * 32 + fr, fq * 8);
#define PG8_SA(b, h) (((b) * 2 + (h)) * HTB)
#define PG8_SB(b, h) ((4 + (b) * 2 + (h)) * HTB)
#define PG8_STAGE(bufoff, gbase, voff) do { _Pragma("unroll") for (int _i = 0; _i < 2; ++_i) \
        __builtin_amdgcn_global_load_lds((const unsigned*)((const char*)(gbase) + (voff)[_i]), (PG8_LAS unsigned*)(lds + (bufoff) + ldsw + _i * 8192), 16, 0, 0); } while (0)
#define PG8_LDA(dst, b, h) do { if constexpr (FP8) { _Pragma("unroll") for (int m = 0; m < 4; ++m) dst##8[m] = __builtin_shufflevector(*(const PG8_LAS v4i32*)(lds + PG8_SA(b, h) + aoff + m * 2048), *(const PG8_LAS v4i32*)(lds + PG8_SA(b, h) + aoff + m * 2048 + 1024), 0, 1, 2, 3, 4, 5, 6, 7); } \
    else { _Pragma("unroll") for (int m = 0; m < 4; ++m) _Pragma("unroll") for (int k = 0; k < 2; ++k) dst[m][k] = *(const PG8_LAS bf16x8*)(lds + PG8_SA(b, h) + aoff + m * 2048 + k * 1024); } } while (0)
#define PG8_LDB(dst, b, h) do { if constexpr (FP8) { _Pragma("unroll") for (int n = 0; n < 2; ++n) dst##8[n] = __builtin_shufflevector(*(const PG8_LAS v4i32*)(lds + PG8_SB(b, h) + boff + n * 2048), *(const PG8_LAS v4i32*)(lds + PG8_SB(b, h) + boff + n * 2048 + 1024), 0, 1, 2, 3, 4, 5, 6, 7); } \
    else { _Pragma("unroll") for (int n = 0; n < 2; ++n) _Pragma("unroll") for (int k = 0; k < 2; ++k) dst[n][k] = *(const PG8_LAS bf16x8*)(lds + PG8_SB(b, h) + boff + n * 2048 + k * 1024); } } while (0)
#define PG8_MMA(ai, bj, At, Bt) do { __builtin_amdgcn_s_setprio(1); _Pragma("unroll") for (int m = 0; m < 4; ++m) _Pragma("unroll") for (int n = 0; n < 2; ++n) { \
        if constexpr (FP8) { asm volatile("v_mfma_scale_f32_16x16x128_f8f6f4 %0, %1, %2, %0, %3, %4 op_sel_hi:[0,0,0]" : "+v"(acc[ai][bj][m][n]) : "v"(Bt##8[n]), "v"(At##8[m]), "v"(scl_w), "v"(scl_a)); } \
        else { _Pragma("unroll") for (int k = 0; k < 2; ++k) acc[ai][bj][m][n] = __builtin_amdgcn_mfma_f32_16x16x32_bf16(Bt[n][k], At[m][k], acc[ai][bj][m][n], 0, 0, 0); } } \
        __builtin_amdgcn_s_setprio(0); } while (0)
#define PG8_WAIT_V(n) asm volatile("s_waitcnt vmcnt(" #n ")" ::: "memory")
#define PG8_WAIT_L(n) asm volatile("s_waitcnt lgkmcnt(" #n ")" ::: "memory")
#define PG8_BAR __builtin_amdgcn_s_barrier()
#define PG8_SCHED __builtin_amdgcn_sched_barrier(0)
    Unit cur, nxt; int ui = 0;
    if (!S.next(0, cur)) return;
    f32x4 acc[2][2][4][2];
#pragma unroll
    for (int a = 0; a < 2; ++a)
#pragma unroll
        for (int b = 0; b < 2; ++b)
#pragma unroll
            for (int m = 0; m < 4; ++m)
#pragma unroll
                for (int n = 0; n < 2; ++n) acc[a][b][m][n] = (f32x4){0.f, 0.f, 0.f, 0.f};
    bf16x8 At[4][2], B0[2][2], B1[2][2];
    const int scl_w = 0x79797979, scl_a = 0x7F7F7F7F;
    v8i32 At8[4], B08[2], B18[2];
    const char* cA = (const char*)g.A + (size_t)cur.pm * tstep; const char* cB = (const char*)g.Bt + (size_t)cur.pn * tstep;
    S.a_ready(cur);
    if constexpr (SP2) {
        PG8_STAGE(PG8_SB(0, 0), cB, voffB); PG8_STAGE(PG8_SB(0, 1), cB + hstep, voffB); PG8_STAGE(PG8_SA(0, 0), cA, voffA); PG8_STAGE(PG8_SA(0, 1), cA + hstep, voffA);
        if (wr == 1) PG8_BAR;
        PG8_WAIT_V(2); PG8_BAR;
        PG8_STAGE(PG8_SB(1, 0), cB + kstep, voffB); PG8_STAGE(PG8_SA(1, 0), cA + kstep, voffA); PG8_STAGE(PG8_SB(1, 1), cB + hstep + kstep, voffB);
        PG8_WAIT_V(6); PG8_BAR;
    } else {
        PG8_STAGE(PG8_SB(0, 0), cB, voffB); PG8_STAGE(PG8_SA(0, 0), cA, voffA); PG8_STAGE(PG8_SB(0, 1), cB + hstep, voffB); PG8_STAGE(PG8_SA(0, 1), cA + hstep, voffA);
        if (wr == 1) PG8_BAR;
        PG8_WAIT_V(4); PG8_BAR;
        PG8_STAGE(PG8_SB(1, 0), cB + kstep, voffB); PG8_STAGE(PG8_SA(1, 0), cA + kstep, voffA); PG8_STAGE(PG8_SB(1, 1), cB + hstep + kstep, voffB);
        PG8_WAIT_V(6); PG8_BAR;
    }
    for (;;) {
        const bool has_next = S.next(ui + 1, nxt);
        const char* nA = has_next ? (const char*)g.A + (size_t)nxt.pm * tstep : cA; const char* nB = has_next ? (const char*)g.Bt + (size_t)nxt.pn * tstep : cB;
        for (int hf = 0; hf < (MID ? 2 : 1); ++hf) {
        if constexpr (MID) { if (hf == 1) E.mid(acc, cur, wr, wc, fr, fq); }
        for (int t = MID ? hf * (nt >> 1) : 0; t < (MID ? (hf + 1) * (nt >> 1) : nt); t += 2) {
            const bool last = (t == nt - 2);
            const char* a1 = cA + (size_t)(t + 1) * kstep;
            const char* a2 = last ? nA : cA + (size_t)(t + 2) * kstep; const char* b2 = last ? nB : cB + (size_t)(t + 2) * kstep;
            const char* a3 = a2 + kstep; const char* b3 = b2 + kstep;
            if (last && has_next) S.a_ready(nxt);
            if constexpr (SP2) {
            PG8_LDB(B0, 0, 0); PG8_LDB(B1, 0, 1); PG8_SCHED; PG8_LDA(At, 0, 0); PG8_STAGE(PG8_SA(1, 1), a1 + hstep, voffA);
            PG8_WAIT_V(8); PG8_WAIT_L(0); PG8_BAR; PG8_MMA(0, 0, At, B0); PG8_MMA(0, 1, At, B1); PG8_BAR; PG8_SCHED;
            PG8_LDA(At, 0, 1); PG8_STAGE(PG8_SB(0, 0), b2, voffB); PG8_STAGE(PG8_SB(0, 1), b2 + hstep, voffB); PG8_STAGE(PG8_SA(0, 0), a2, voffA);
            PG8_WAIT_V(8); PG8_WAIT_L(0); PG8_BAR; PG8_MMA(1, 0, At, B0); PG8_MMA(1, 1, At, B1); PG8_BAR; PG8_SCHED;
            PG8_LDB(B0, 1, 0); PG8_LDB(B1, 1, 1); PG8_SCHED; PG8_LDA(At, 1, 0); PG8_STAGE(PG8_SA(0, 1), a2 + hstep, voffA);
            PG8_WAIT_V(8); PG8_WAIT_L(0); PG8_BAR; PG8_MMA(0, 0, At, B0); PG8_MMA(0, 1, At, B1); PG8_BAR; PG8_SCHED;
            PG8_LDA(At, 1, 1); PG8_STAGE(PG8_SB(1, 0), b3, voffB); PG8_STAGE(PG8_SB(1, 1), b3 + hstep, voffB); PG8_STAGE(PG8_SA(1, 0), a3, voffA);
            PG8_WAIT_V(8); PG8_WAIT_L(0); PG8_BAR; PG8_MMA(1, 0, At, B0); PG8_MMA(1, 1, At, B1); PG8_BAR; PG8_SCHED;
            } else {
            PG8_LDB(B0, 0, 0); PG8_SCHED; PG8_LDA(At, 0, 0); PG8_STAGE(PG8_SA(1, 1), a1 + hstep, voffA);
            PG8_WAIT_L(8); PG8_BAR; PG8_WAIT_L(0); PG8_MMA(0, 0, At, B0); PG8_BAR; PG8_SCHED;
            PG8_LDB(B1, 0, 1); PG8_STAGE(PG8_SB(0, 0), b2, voffB);
            PG8_BAR; PG8_WAIT_L(0); PG8_MMA(0, 1, At, B1); PG8_BAR;
            PG8_LDA(At, 0, 1); PG8_STAGE(PG8_SA(0, 0), a2, voffA);
            PG8_BAR; PG8_WAIT_L(0); PG8_MMA(1, 0, At, B0); PG8_BAR; PG8_SCHED;
            PG8_STAGE(PG8_SB(0, 1), b2 + hstep, voffB);
            PG8_WAIT_V(6); PG8_BAR; PG8_MMA(1, 1, At, B1); PG8_BAR;
            PG8_LDB(B0, 1, 0); PG8_SCHED; PG8_LDA(At, 1, 0); PG8_STAGE(PG8_SA(0, 1), a2 + hstep, voffA);
            PG8_WAIT_L(8); PG8_BAR; PG8_WAIT_L(0); PG8_MMA(0, 0, At, B0); PG8_BAR; PG8_SCHED;
            PG8_LDB(B1, 1, 1); PG8_STAGE(PG8_SB(1, 0), b3, voffB);
            PG8_BAR; PG8_WAIT_L(0); PG8_MMA(0, 1, At, B1); PG8_BAR;
            PG8_LDA(At, 1, 1); PG8_STAGE(PG8_SA(1, 0), a3, voffA);
            PG8_BAR; PG8_WAIT_L(0); PG8_MMA(1, 0, At, B0); PG8_BAR; PG8_SCHED;
            PG8_STAGE(PG8_SB(1, 1), b3 + hstep, voffB);
            PG8_WAIT_V(6); PG8_BAR; PG8_MMA(1, 1, At, B1); PG8_BAR;
            }
        }
        }
        if constexpr (FP8) asm volatile("s_nop 15\n\ts_nop 15\n\ts_nop 15" ::: "memory");
        if constexpr (ALIGN_EPI) { if (wr == 0) PG8_BAR; }
        if constexpr (!Epi::AFTER_DRAIN) { E(acc, cur, wr, wc, fr, fq); S.done(cur); }
        if (!has_next) break;
#pragma unroll
        for (int a = 0; a < 2; ++a)
#pragma unroll
            for (int b = 0; b < 2; ++b)
#pragma unroll
                for (int m = 0; m < 4; ++m)
#pragma unroll
                    for (int n = 0; n < 2; ++n) acc[a][b][m][n] = (f32x4){0.f, 0.f, 0.f, 0.f};
        cur = nxt; cA = nA; cB = nB; ++ui;
        if constexpr (ALIGN_EPI) { if (wr == 1) PG8_BAR; }
    }
    PG8_WAIT_V(0);
    if constexpr (!ALIGN_EPI) { if (wr == 0) PG8_BAR; }
    PG8_BAR;
    if constexpr (Epi::AFTER_DRAIN) { E.fused(acc, cur, wr, wc, fr, fq, lds, wid, lane); S.done(cur); }
#undef PG8_SA
#undef PG8_SB
#undef PG8_STAGE
#undef PG8_LDA
#undef PG8_LDB
#undef PG8_MMA
#undef PG8_WAIT_V
#undef PG8_WAIT_L
#undef PG8_BAR
#undef PG8_SCHED
}
}

constexpr int NWAVES = 8;
constexpr int S = 8192, D = 4096, FF = 11008, DIN = 20488, NP = 16384;
constexpr int NPH = 14;
#ifndef MK_ONE_LAUNCH
#define MK_ONE_LAUNCH 1
#endif
constexpr float ALPHA = 1.1892071150027210667f;
constexpr float LN_EPS = 1e-5f, HEAD_EPS = 1e-6f;

constexpr size_t MiB = 1u << 20, KiB = 1u << 10;
constexpr size_t WS_CTL = 0, CTL_ZERO_BYTES = 1 * MiB;
constexpr size_t WS_WIF = 1 * MiB;
constexpr size_t WS_GATES = WS_WIF + 128 * KiB;
constexpr size_t WS_AARR = WS_GATES + 256 * KiB;
constexpr size_t WS_MARR = WS_AARR + 128 * KiB;
constexpr size_t WS_BMARR = WS_MARR + 128 * KiB;
constexpr size_t WS_NPREV = WS_BMARR + 128 * KiB;
constexpr size_t WS_WGU1 = 4 * MiB;
constexpr size_t WS_WD1 = WS_WGU1 + 172 * MiB;
constexpr size_t WS_WIN = WS_WD1 + 86 * MiB;
constexpr size_t WS_WPM = WS_WIN + 160 * MiB;
constexpr size_t WS_WPR = WS_WPM + 16 * MiB;
constexpr size_t WS_WO = WS_WPR + 16 * MiB;
constexpr size_t WS_WGU2 = WS_WO + 32 * MiB;
constexpr size_t WS_WD2 = WS_WGU2 + 172 * MiB;
constexpr size_t WS_R1 = WS_WD2 + 86 * MiB;
constexpr size_t WS_T = WS_R1 + 256 * MiB;
constexpr size_t WS_HF = WS_T + 128 * MiB;
constexpr size_t WS_HB = WS_HF + 128 * MiB;
constexpr size_t WS_XB = WS_HB + 64 * MiB;
constexpr size_t WS_END = WS_XB + 64 * MiB;
constexpr size_t WS_VT = WS_WGU1;
constexpr size_t WS_U = WS_END;
constexpr size_t WS_END2 = WS_U + 128 * MiB;
constexpr size_t WS_QA = WS_WGU1 + 64 * MiB;
constexpr size_t WS_STATS = 2 * MiB;
constexpr size_t WS_PART = WS_WGU1 + 128 * MiB;
constexpr size_t WS_KTW = WS_T + 64 * MiB;
constexpr size_t WS_Y = WS_HB;
constexpr size_t WS_MRG = WS_XB;
constexpr size_t WS_H8 = WS_XB;
constexpr size_t WS_W8 = WS_WIN + (size_t)6144 * 4096 * 2;
constexpr int CW_BAR = 4096;

constexpr int LDS_BYTES = 147456;
constexpr int MISC_OFF = LDS_BYTES - 512;

#define GAS __attribute__((address_space(1)))
#define LAS __attribute__((address_space(3)))
typedef unsigned short bf16;
typedef unsigned v4u __attribute__((ext_vector_type(4)));
typedef unsigned v2u __attribute__((ext_vector_type(2)));
typedef float f32x4 __attribute__((ext_vector_type(4)));
typedef short bf16x8 __attribute__((ext_vector_type(8)));
typedef float f32x2q __attribute__((ext_vector_type(2)));
#define LDS_WAIT() asm volatile("s_waitcnt lgkmcnt(0)" ::: "memory")
#define VM_WAIT() asm volatile("s_waitcnt vmcnt(0)" ::: "memory")
using pg8::cvt_pk_bf16; using pg8::bf_lo; using pg8::bf_hi; using pg8::fast_sigmoid;

#define XB_TMO      128
#define XB_XCNT(j)  (256  + 64 * (j))
#define XB_XSUB(j)  (1280 + 64 * (j))
#define XB_XGEN(j)  (2304 + 64 * (j))
#define XB_TOP      3328
#define XB_TOPGEN   3392
#define XCD_BAR_WORDS 3456
#define XB_SPIN_CAP (1u << 22)

__device__ __forceinline__ unsigned xb_ld(unsigned* p)              { return __hip_atomic_load(p, __ATOMIC_RELAXED, __HIP_MEMORY_SCOPE_AGENT); }
__device__ __forceinline__ unsigned xb_add(unsigned* p, unsigned v) { return __hip_atomic_fetch_add(p, v, __ATOMIC_RELAXED, __HIP_MEMORY_SCOPE_AGENT); }
__device__ __forceinline__ unsigned xb_xcc_id() { return (unsigned)__builtin_amdgcn_s_getreg((3 << 11) | 20) & 0xFu; }
#define XB_SPIN(cond, bar) do { unsigned _sp = 0; while (cond) { __builtin_amdgcn_s_sleep(1); \
    if ((++_sp & 255u) == 0u) { if (xb_ld(&(bar)[XB_TMO])) break; if (_sp > XB_SPIN_CAP) { atomicAdd(&(bar)[XB_TMO], 1u); break; } } } } while (0)

struct XcdBarrier {
    unsigned* bar; unsigned x;
    volatile LAS unsigned* st;
};

__device__ __forceinline__ XcdBarrier xcd_barrier_post(unsigned* bar, volatile LAS unsigned* st) {
    XcdBarrier b; b.bar = bar; b.x = xb_xcc_id(); b.st = st;
    if (threadIdx.x == 0) (void)xb_add(&bar[XB_XCNT(b.x)], 1u);
    return b;
}
__device__ __forceinline__ void xcd_barrier_complete(unsigned* bar, unsigned x, unsigned& nloc, unsigned& nx) {
    const unsigned G = gridDim.x * gridDim.y * gridDim.z;
    unsigned sum, cnt, mine, sp = 0u;
    for (;;) {
        sum = 0u; cnt = 0u; mine = 0u;
#pragma unroll
        for (unsigned j = 0; j < 16; ++j) { const unsigned c = xb_ld(&bar[XB_XCNT(j)]); sum += c; cnt += (c > 0u) ? 1u : 0u; mine = (j == x) ? c : mine; }
        if (sum == G) break;
        __builtin_amdgcn_s_sleep(1);
        if ((++sp & 255u) == 0u) { if (xb_ld(&bar[XB_TMO])) break; if (sp > XB_SPIN_CAP) { atomicAdd(&bar[XB_TMO], 1u); break; } }
    }
    nloc = mine > 0u ? mine : 1u; nx = cnt > 0u ? cnt : 1u;
}

__device__ __forceinline__ void xcd_barrier(const XcdBarrier& b) {
    asm volatile("s_waitcnt vmcnt(0)" ::: "memory");
    __syncthreads();
    if (threadIdx.x == 0) {
        unsigned* bar = b.bar;
        __builtin_amdgcn_s_waitcnt(0);
        unsigned nloc = b.st[0], nx = b.st[1];
        if (nloc == 0u) { xcd_barrier_complete(bar, b.x, nloc, nx); b.st[0] = nloc; b.st[1] = nx; }
        const unsigned old = xb_add(&bar[XB_XSUB(b.x)], 1u);
        const unsigned gen = old / nloc;
        if (old + 1u == (gen + 1u) * nloc) {
            __builtin_amdgcn_fence(__ATOMIC_RELEASE, "agent");
            asm volatile("s_waitcnt vmcnt(0)" ::: "memory");
            const unsigned og = xb_add(&bar[XB_TOP], 1u);
            const unsigned tg = og / nx;
            if (og + 1u == (tg + 1u) * nx) xb_add(&bar[XB_TOPGEN], 1u);
            else XB_SPIN(xb_ld(&bar[XB_TOPGEN]) == tg, bar);
            __builtin_amdgcn_fence(__ATOMIC_ACQUIRE, "agent");
            xb_add(&bar[XB_XGEN(b.x)], 1u);
            asm volatile("s_waitcnt vmcnt(0)" ::: "memory");
        } else {
            XB_SPIN(xb_ld(&bar[XB_XGEN(b.x)]) == gen, bar);
            __builtin_amdgcn_fence(__ATOMIC_ACQUIRE, "agent");
            asm volatile("s_waitcnt vmcnt(0)" ::: "memory");
        }
    }
    __syncthreads();
}

__device__ __forceinline__ float wave_sum(float v) {
#pragma unroll
    for (int o = 1; o < 64; o <<= 1) v += __shfl_xor(v, o);
    return v;
}
__device__ __forceinline__ float bf2f(unsigned short b) { return __uint_as_float(((unsigned)b) << 16); }
__device__ __forceinline__ float fast_silu(float x) { return x * fast_sigmoid(x); }

struct Frame {
    LAS unsigned char* lds;
    unsigned char* ws;
    const void* const* in;
    int tid, lane, wave, vcu, G;
};

struct Seg { int in_idx, ldw, col0, ntn, ldt, row0, map, dst_mib, tile_end, koff; };
__constant__ Seg c_segs[16] = {
    { 2, FF, 0, 172, D, 0, 1, (int)(WS_WGU1 / MiB), 11008, 0},
    { 3, FF, 0, 172, D, 0, 2, (int)(WS_WGU1 / MiB), 22016, 0},
    { 4, D, 0, 64, FF, 0, 0, (int)(WS_WD1 / MiB), 33024, 0},
    { 7, DIN, 0, 32, D, 0, 0, (int)(WS_WIN / MiB), 35072, 0},
    { 7, DIN, 4096, 32, D, 0, 3, (int)(WS_WIN / MiB), 37120, 0},
    { 7, DIN, 6152, 32, D, 2048, 0, (int)(WS_WIN / MiB), 39168, 0},
    { 7, DIN, 10248, 32, D, 4096, 0, (int)(WS_WIN / MiB), 41216, 0},
    { 7, DIN, 12296, 128, D, 2048, 3, (int)(WS_WIN / MiB), 49408, 0},
    { 7, DIN, 2048, 32, D, 16384, 0, (int)(WS_WIN / MiB), 51456, 0},
    { 7, DIN, 8200, 32, D, 18432, 0, (int)(WS_WIN / MiB), 53504, 0},
    {13, D, 0, 64, D, 0, 0, (int)(WS_WPM / MiB), 55552, 0},
    {14, D, 0, 64, D, 0, 0, (int)(WS_WPM / MiB), 57600, 2048},
    {15, D, 0, 64, D, 0, 0, (int)(WS_WO / MiB), 61696, 0},
    {18, FF, 0, 172, D, 0, 1, (int)(WS_WGU2 / MiB), 72704, 0},
    {19, FF, 0, 172, D, 0, 2, (int)(WS_WGU2 / MiB), 83712, 0},
    {20, D, 0, 64, FF, 0, 0, (int)(WS_WD2 / MiB), 94720, 0},
};
constexpr int N_TILES = 94720;

struct Args { const void* in[23]; float* out; unsigned char* ws; int ph_lo, ph_hi; };

struct TileDesc { const float* p; bf16* d; int ldw, ldt, fp8; };
__device__ __forceinline__ TileDesc p0_decode(const Args& a, unsigned char* ws, int it, int lane) {
    int si = 0;
#pragma unroll
    for (int q = 0; q < 15; ++q) si += (it >= c_segs[q].tile_end) ? 1 : 0;
    const Seg sg = c_segs[si];
    const int t = it - (si ? c_segs[si - 1].tile_end : 0);
    const int kg = 4;
    const int g4 = t / (kg * sg.ntn), rem = t - g4 * kg * sg.ntn, nb = rem / kg, kb = kg * g4 + (rem - nb * kg);
    const int n0 = 64 * nb;
    int r0 = sg.row0 + n0;
    if (sg.map == 1 || sg.map == 2) r0 = (n0 >> 7) * 256 + (n0 & 127) + (sg.map == 2 ? 128 : 0);
    TileDesc td;
    td.ldw = sg.ldw; td.ldt = sg.ldt; td.fp8 = sg.map == 3;
    if (sg.map == 3) {
        td.p = (const float*)a.in[sg.in_idx] + (size_t)(64 * kb + 4 * (lane >> 4)) * sg.ldw + sg.col0 + n0 + 4 * (lane & 15);
        td.d = (bf16*)(ws + WS_W8 + (size_t)(sg.row0 + n0 + (lane >> 2)) * 4096 + 64 * kb + 16 * (lane & 3));
        return td;
    }
    td.p = (const float*)a.in[sg.in_idx] + (size_t)(64 * kb + 2 * (lane >> 4)) * sg.ldw + sg.col0 + n0 + 4 * (lane & 15);
    td.d = (bf16*)(ws + (size_t)sg.dst_mib * MiB) + (size_t)(r0 + (lane >> 3)) * sg.ldt + sg.koff + 64 * kb + 8 * (lane & 7);
    return td;
}
__device__ __forceinline__ void p0_load(const TileDesc& td, f32x4 (&v)[16]) {
    if (td.fp8) {
#pragma unroll
        for (int i = 0; i < 4; ++i)
#pragma unroll
            for (int e = 0; e < 4; ++e) v[4 * i + e] = __builtin_nontemporal_load((const f32x4*)(td.p + (size_t)(16 * i + e) * td.ldw));
        return;
    }
#pragma unroll
    for (int i = 0; i < 8; ++i) { v[2 * i] = __builtin_nontemporal_load((const f32x4*)(td.p + (size_t)(8 * i) * td.ldw)); v[2 * i + 1] = __builtin_nontemporal_load((const f32x4*)(td.p + (size_t)(8 * i + 1) * td.ldw)); }
}
__device__ __forceinline__ unsigned pack4_fp8(float a, float b, float c, float d) { int w = 0; w = __builtin_amdgcn_cvt_pk_fp8_f32(a, b, w, false); w = __builtin_amdgcn_cvt_pk_fp8_f32(c, d, w, true); return (unsigned)w; }
__device__ __forceinline__ void p0_store(const TileDesc& td, const f32x4 (&v)[16], LAS unsigned* scr, int lane) {
    const int q = lane & 15, r = lane >> 4;
    if (td.fp8) {
#pragma unroll
        for (int i = 0; i < 4; ++i) { LAS unsigned* s = scr + (4 * q) * 16 + 4 * (i ^ (q & 3)) + r;
            s[0] = pack4_fp8(v[4 * i].x * 64.f, v[4 * i + 1].x * 64.f, v[4 * i + 2].x * 64.f, v[4 * i + 3].x * 64.f);
            s[16] = pack4_fp8(v[4 * i].y * 64.f, v[4 * i + 1].y * 64.f, v[4 * i + 2].y * 64.f, v[4 * i + 3].y * 64.f);
            s[32] = pack4_fp8(v[4 * i].z * 64.f, v[4 * i + 1].z * 64.f, v[4 * i + 2].z * 64.f, v[4 * i + 3].z * 64.f);
            s[48] = pack4_fp8(v[4 * i].w * 64.f, v[4 * i + 1].w * 64.f, v[4 * i + 2].w * 64.f, v[4 * i + 3].w * 64.f); }
        LDS_WAIT();
        const int g = lane & 3;
#pragma unroll
        for (int j = 0; j < 4; ++j) { const int n = (lane >> 2) + 16 * j;
            const v4u o = *(const LAS v4u*)(scr + n * 16 + 4 * (g ^ ((n >> 2) & 3)));
            __builtin_nontemporal_store(o, (v4u*)((unsigned char*)td.d + (size_t)(16 * j) * 4096)); }
        LDS_WAIT();
        return;
    }
#pragma unroll
    for (int i = 0; i < 8; ++i) { LAS unsigned* s = scr + (4 * q) * 32 + 4 * (i ^ (q & 7)) + r;
        s[0] = cvt_pk_bf16(v[2 * i].x, v[2 * i + 1].x); s[32] = cvt_pk_bf16(v[2 * i].y, v[2 * i + 1].y); s[64] = cvt_pk_bf16(v[2 * i].z, v[2 * i + 1].z); s[96] = cvt_pk_bf16(v[2 * i].w, v[2 * i + 1].w); }
    LDS_WAIT();
    const int g = lane & 7;
#pragma unroll
    for (int j = 0; j < 8; ++j) { const int n = (lane >> 3) + 8 * j;
        const v4u o = *(const LAS v4u*)(scr + n * 32 + 4 * (g ^ ((n >> 2) & 7)));
        __builtin_nontemporal_store(o, (v4u*)(td.d + (size_t)(8 * j) * td.ldt)); }
    LDS_WAIT();
}

__device__ __forceinline__ void p0_tiles(Frame& F, const Args& a, int t_lo, int t_hi, int gw, int ngw) {
    int tz_ = threadIdx.x; asm volatile("" : "+v"(tz_)); const int lane_ = tz_ & 63;
    LAS unsigned* scr = (LAS unsigned*)(F.lds + F.wave * 8192);
    f32x4 va[16], vb[16], vc[16];
    TileDesc da, db, dc;
    const int it0 = t_lo + gw;
    da = p0_decode(a, F.ws, it0 < t_hi ? it0 : t_lo, lane_); db = da; dc = da;
    if (it0 < t_hi) p0_load(da, va);
    if (it0 + ngw < t_hi) { db = p0_decode(a, F.ws, it0 + ngw, lane_); p0_load(db, vb); }
    for (int it = it0; it < t_hi; it += 3 * ngw) {
        if (it + 2 * ngw < t_hi) { dc = p0_decode(a, F.ws, it + 2 * ngw, lane_); p0_load(dc, vc); }
        p0_store(da, va, scr, lane_);
        if (it + 3 * ngw < t_hi) { da = p0_decode(a, F.ws, it + 3 * ngw, lane_); p0_load(da, va); }
        if (it + ngw < t_hi) p0_store(db, vb, scr, lane_);
        if (it + 4 * ngw < t_hi) { db = p0_decode(a, F.ws, it + 4 * ngw, lane_); p0_load(db, vb); }
        if (it + 2 * ngw < t_hi) p0_store(dc, vc, scr, lane_);
    }
}
constexpr int T_WD1_LO = 22016, T_WD1_HI = 33024;
constexpr int T_LATE = 83712;
__device__ __forceinline__ void p0_convert(Frame& F, const Args& a) {
    int tz_ = threadIdx.x; asm volatile("" : "+v"(tz_)); const int lane_ = tz_ & 63;
    p0_tiles(F, a, 0, T_WD1_LO, F.vcu * NWAVES + F.wave, F.G * NWAVES);
    p0_tiles(F, a, F.G == 256 ? T_WD1_HI : T_WD1_LO, F.G == 256 ? T_LATE : N_TILES, F.vcu * NWAVES + F.wave, F.G * NWAVES);
    const int gt = (F.vcu * NWAVES + F.wave) * 64 + lane_, NGT = F.G * NWAVES * 64;
    if (gt < 8 * D) { const int g = gt >> 12, k = gt & (D - 1); ((float*)(F.ws + WS_WIF))[gt] = ((const float*)a.in[7])[(size_t)k * DIN + 6144 + g]; }
    const float* x = (const float*)a.in[0]; bf16* xb = (bf16*)(F.ws + WS_XB);
    for (size_t i = (size_t)gt * 8; i < (size_t)S * D; i += (size_t)NGT * 8) {
        const f32x4 u0 = *(const f32x4*)(x + i), u1 = *(const f32x4*)(x + i + 4);
        v4u o; o.x = cvt_pk_bf16(u0.x, u0.y); o.y = cvt_pk_bf16(u0.z, u0.w); o.z = cvt_pk_bf16(u1.x, u1.y); o.w = cvt_pk_bf16(u1.z, u1.w);
        *(v4u*)(xb + i) = o;
    }
}

template <int MODE> __device__ __forceinline__ void ln_phase(Frame& F, const float* __restrict__ T, const float* __restrict__ w, const float* __restrict__ b,
                                                             float* __restrict__ OF, bf16* __restrict__ OB, const float* __restrict__ if_bias) {
    int tz_ = threadIdx.x; asm volatile("" : "+v"(tz_)); const int tid_ = tz_, lane_ = tz_ & 63;
    if (MODE == 1) {
        const v4u* srcw = (const v4u*)(F.ws + WS_WIF); LAS v4u* dl = (LAS v4u*)F.lds;
        for (int i = tid_; i < 8192; i += NWAVES * 64) dl[i] = srcw[i];
        LDS_WAIT(); __syncthreads();
    }
    const int gw = F.vcu * NWAVES + F.wave, NGW = F.G * NWAVES;
    const f32x4* w4 = (const f32x4*)w + lane_; const f32x4* b4 = (const f32x4*)b + lane_;
    const LAS f32x4* wl = (const LAS f32x4*)F.lds + lane_;
    for (int row = gw; row < S; row += NGW) {
        const f32x4* xr = (const f32x4*)(T + (size_t)row * D) + lane_;
        float s, ss;
        { const f32x2q pv = ((const f32x2q*)(F.ws + WS_PART))[(size_t)row * 64 + lane_]; s = wave_sum(pv.x); ss = wave_sum(pv.y); }
        const float mean = s * (1.f / D);
        const float var = fmaxf(ss * (1.f / D) - mean * mean, 0.f);
        const float rstd = 1.f / sqrtf(var + LN_EPS);
        f32x4* of = (f32x4*)(OF + (size_t)row * D) + lane_;
        if (MODE != 3 && lane_ == 0) { float* st = (float*)(F.ws + WS_STATS) + 2 * row; st[0] = mean; st[1] = rstd; }
        v2u* ob = (v2u*)(OB + (size_t)row * D) + lane_;
        float g[8];
#pragma unroll
        for (int q = 0; q < 8; ++q) g[q] = 0.f;
        constexpr int LN_UNR = MODE == 1 ? 4 : 8;
#pragma unroll LN_UNR
        for (int j = 0; j < 16; ++j) {
            const f32x4 y = (__builtin_nontemporal_load(xr + 64 * j) - mean) * rstd * w4[64 * j] + b4[64 * j];
            if (MODE == 3) of[64 * j] = y;
            if (MODE != 3) { v2u o; o.x = cvt_pk_bf16(y.x, y.y); o.y = cvt_pk_bf16(y.z, y.w); ob[64 * j] = o; }
            if (MODE == 1) ((unsigned*)(F.ws + WS_H8 + (size_t)row * D))[lane_ + 64 * j] = pack4_fp8(y.x, y.y, y.z, y.w);
            if (MODE == 1) {
#pragma unroll
                for (int q = 0; q < 8; ++q) { const f32x4 ww = wl[q * 1024 + 64 * j]; g[q] += (y.x * ww.x + y.y * ww.y) + (y.z * ww.z + y.w * ww.w); }
            }
        }
        if (MODE == 1) {
#pragma unroll
            for (int q = 0; q < 8; ++q) g[q] = wave_sum(g[q]);
            if (lane_ == 0) { float* go = (float*)(F.ws + WS_GATES) + (size_t)row * 8;
#pragma unroll
                for (int q = 0; q < 8; ++q) go[q] = g[q] + if_bias[q]; }
        }
    }
}

__device__ __forceinline__ float log_sigmoid(float x) { return fminf(x, 0.f) - log1pf(expf(-fabsf(x))); }
__device__ __forceinline__ void gate_scan(Frame& F, int head) {
    int tz_ = threadIdx.x; asm volatile("" : "+v"(tz_)); const int tid_ = tz_, lane_ = tz_ & 63;
    const float* gates = (const float*)(F.ws + WS_GATES);
    float* aArr = (float*)(F.ws + WS_AARR) + head * S; float* MArr = (float*)(F.ws + WS_MARR) + head * S; float* BmArr = (float*)(F.ws + WS_BMARR) + head * S;
    LAS float* sc = (LAS float*)F.lds;
    const int t0 = tid_ * 16;
    float lf[16], iv[16];
    float run = 0.f;
    {
        LAS float* gl = sc + 64;
        const f32x4* g4 = (const f32x4*)gates;
#pragma unroll 8
        for (int k = 0; k < 32; ++k) { const int q = tid_ + 512 * k; const f32x4 v = g4[q]; gl[(q & 1) * S + (q >> 1)] = v[head]; }
        LDS_WAIT(); __syncthreads();
#pragma unroll
        for (int j = 0; j < 16; ++j) { iv[j] = gl[t0 + j]; run += log_sigmoid(gl[S + t0 + j]); lf[j] = run; }
    }
    float incl = run;
#pragma unroll
    for (int o = 1; o < 64; o <<= 1) { const float u = __shfl_up(incl, o); if (lane_ >= o) incl += u; }
    if (lane_ == 63) sc[F.wave] = incl;
    LDS_WAIT(); __syncthreads();
    float woff = 0.f;
    for (int w = 0; w < F.wave; ++w) woff += sc[w];
    const float excl = woff + incl - run;
    float mx = -INFINITY;
#pragma unroll
    for (int j = 0; j < 16; ++j) { const float B = excl + lf[j]; const float av = iv[j] - B; mx = fmaxf(mx, av); aArr[t0 + j] = av; lf[j] = B; iv[j] = mx; }
    float im = mx;
#pragma unroll
    for (int o = 1; o < 64; o <<= 1) { const float u = __shfl_up(im, o); if (lane_ >= o) im = fmaxf(im, u); }
    if (lane_ == 63) sc[16 + F.wave] = im;
    LDS_WAIT(); __syncthreads();
    float wm = -INFINITY;
    for (int w = 0; w < F.wave; ++w) wm = fmaxf(wm, sc[16 + w]);
    float prev = __shfl_up(im, 1); if (lane_ == 0) prev = -INFINITY;
    const float em = fmaxf(wm, prev);
#pragma unroll
    for (int j = 0; j < 16; ++j) { const float M = fmaxf(0.f, fmaxf(em, iv[j])); MArr[t0 + j] = M; BmArr[t0 + j] = lf[j] + M; }
    __syncthreads();
}

constexpr int P5_KP = 258;
__device__ __forceinline__ void p5_states(Frame& F, const Args& a) {
    int tz_ = threadIdx.x; asm volatile("" : "+v"(tz_)); const int tid_ = tz_;
    const bf16* proj = (const bf16*)(F.ws + WS_R1); bf16* QA = (bf16*)(F.ws + WS_QA); const bf16* VT = (const bf16*)(F.ws + WS_VT); bf16* U = (bf16*)(F.ws + WS_U);
    const float* convw = (const float*)a.in[9]; const float* convb = (const float*)a.in[10]; const int* positions = (const int*)a.in[1];
    LAS bf16* KW = (LAS bf16*)F.lds;
    float invf[16];
#pragma unroll
    for (int e = 0; e < 16; ++e) invf[e] = exp2f(-(float)((tid_ & 7) * 16 + e) * (13.287712379549449f / 128.0f));
    for (int unit = F.vcu; unit < 512; unit += F.G) {
        int tu = tid_; asm volatile("" : "+v"(tu));
        const int tl = tu >> 3, cb = tu & 7, fr = tu & 15, fq = (tu & 63) >> 4;
        const int mh = unit >> 6, c = unit & 63;
        if (mh < 4) {
            const int head = mh, tg = tu >> 5, cq = tu & 31, t0 = c * 128 + tg * 8;
            float wkv[8];
            { const float* aA = (const float*)(F.ws + WS_AARR) + head * S + t0; const float Mend = ((const float*)(F.ws + WS_MARR))[head * S + c * 128 + 127];
                const f32x4 a0 = *(const f32x4*)aA, a1 = *(const f32x4*)(aA + 4);
                wkv[0] = __expf(a0.x - Mend); wkv[1] = __expf(a0.y - Mend); wkv[2] = __expf(a0.z - Mend); wkv[3] = __expf(a0.w - Mend);
                wkv[4] = __expf(a1.x - Mend); wkv[5] = __expf(a1.y - Mend); wkv[6] = __expf(a1.z - Mend); wkv[7] = __expf(a1.w - Mend); }
#pragma unroll
            for (int part = 0; part < 2; ++part) {
                const int col = part * 1024 + head * 256 + cq * 8;
                float wt[4][8], bb[8];
#pragma unroll
                for (int j = 0; j < 4; ++j) { const f32x4 w0 = *(const f32x4*)(convw + j * 2048 + col), w1 = *(const f32x4*)(convw + j * 2048 + col + 4);
                    wt[j][0] = w0.x; wt[j][1] = w0.y; wt[j][2] = w0.z; wt[j][3] = w0.w; wt[j][4] = w1.x; wt[j][5] = w1.y; wt[j][6] = w1.z; wt[j][7] = w1.w; }
                { const f32x4 b0 = *(const f32x4*)(convb + col), b1 = *(const f32x4*)(convb + col + 4); bb[0] = b0.x; bb[1] = b0.y; bb[2] = b0.z; bb[3] = b0.w; bb[4] = b1.x; bb[5] = b1.y; bb[6] = b1.z; bb[7] = b1.w; }
                v4u xr[11];
#pragma unroll
                for (int r = 0; r < 11; ++r) { const int tt = t0 - 3 + r; xr[r] = tt >= 0 ? *(const v4u*)(proj + (size_t)tt * NP + col) : (v4u){0u, 0u, 0u, 0u}; }
                const float sc = part == 0 ? 0.0625f : 1.0f;
#pragma unroll
                for (int tk = 0; tk < 8; ++tk) {
                    float acc[8];
#pragma unroll
                    for (int e = 0; e < 8; ++e) acc[e] = bb[e];
#pragma unroll
                    for (int j = 0; j < 4; ++j) { const v4u xv = xr[tk + j];
                        acc[0] += wt[j][0] * bf_lo(xv.x); acc[1] += wt[j][1] * bf_hi(xv.x); acc[2] += wt[j][2] * bf_lo(xv.y); acc[3] += wt[j][3] * bf_hi(xv.y);
                        acc[4] += wt[j][4] * bf_lo(xv.z); acc[5] += wt[j][5] * bf_hi(xv.z); acc[6] += wt[j][6] * bf_lo(xv.w); acc[7] += wt[j][7] * bf_hi(xv.w); }
#pragma unroll
                    for (int e = 0; e < 8; ++e) acc[e] = fast_silu(acc[e]) * sc;
                    v4u o; o.x = cvt_pk_bf16(acc[0], acc[1]); o.y = cvt_pk_bf16(acc[2], acc[3]); o.z = cvt_pk_bf16(acc[4], acc[5]); o.w = cvt_pk_bf16(acc[6], acc[7]);
                    *(v4u*)(QA + (size_t)(t0 + tk) * D + col) = o;
                    if (part == 1) { const float wk = wkv[tk]; LAS unsigned* kd = (LAS unsigned*)(KW + (tg * 8 + tk) * P5_KP + cq * 8);
                        kd[0] = cvt_pk_bf16(acc[0] * wk, acc[1] * wk); kd[1] = cvt_pk_bf16(acc[2] * wk, acc[3] * wk); kd[2] = cvt_pk_bf16(acc[4] * wk, acc[5] * wk); kd[3] = cvt_pk_bf16(acc[6] * wk, acc[7] * wk); }
                }
            }
        } else {
#pragma unroll 1
        for (int sub = 0; sub < 2; ++sub) {
            const int lrow = sub * 64 + tl, tok = c * 128 + lrow;
            {
                const int head = mh - 4, d0 = cb * 16;
                const float posf = (float)positions[tok];
                const float lg = logf(1.0f - exp2f(-5.0f - (float)head));
                const float gwt = __expf(lg * (float)(127 - (tok & 127)));
                float cs[16], sn[16];
#pragma unroll
                for (int e = 0; e < 16; ++e) {
                    const float inv = invf[e];
                    const float p = posf * inv, perr = fmaf(posf, inv, -p);
                    const float k = rintf(p * 0.15915494309189535f);
                    float r = fmaf(-k, 6.28125f, p); r += perr; r = fmaf(-k, 0.0019353071795864769f, r);
                    const float rev = r * 0.15915494309189535f;
                    cs[e] = __builtin_amdgcn_cosf(rev); sn[e] = __builtin_amdgcn_sinf(rev);
                }
#pragma unroll
                for (int part = 0; part < 2; ++part) {
                    const int pcol = 2048 + part * 1024 + head * 256 + d0, qcol = 2048 + part * 1024 + head * 256 + d0;
                    const v4u a0 = *(const v4u*)(proj + (size_t)tok * NP + pcol), a1 = *(const v4u*)(proj + (size_t)tok * NP + pcol + 8);
                    const v4u b0 = *(const v4u*)(proj + (size_t)tok * NP + pcol + 128), b1 = *(const v4u*)(proj + (size_t)tok * NP + pcol + 136);
                    float x1[16], x2[16];
                    x1[0] = bf_lo(a0.x); x1[1] = bf_hi(a0.x); x1[2] = bf_lo(a0.y); x1[3] = bf_hi(a0.y); x1[4] = bf_lo(a0.z); x1[5] = bf_hi(a0.z); x1[6] = bf_lo(a0.w); x1[7] = bf_hi(a0.w);
                    x1[8] = bf_lo(a1.x); x1[9] = bf_hi(a1.x); x1[10] = bf_lo(a1.y); x1[11] = bf_hi(a1.y); x1[12] = bf_lo(a1.z); x1[13] = bf_hi(a1.z); x1[14] = bf_lo(a1.w); x1[15] = bf_hi(a1.w);
                    x2[0] = bf_lo(b0.x); x2[1] = bf_hi(b0.x); x2[2] = bf_lo(b0.y); x2[3] = bf_hi(b0.y); x2[4] = bf_lo(b0.z); x2[5] = bf_hi(b0.z); x2[6] = bf_lo(b0.w); x2[7] = bf_hi(b0.w);
                    x2[8] = bf_lo(b1.x); x2[9] = bf_hi(b1.x); x2[10] = bf_lo(b1.y); x2[11] = bf_hi(b1.y); x2[12] = bf_lo(b1.z); x2[13] = bf_hi(b1.z); x2[14] = bf_lo(b1.w); x2[15] = bf_hi(b1.w);
                    const float sc = part == 1 ? 0.0625f : 1.0f;
                    float o1[16], o2[16];
#pragma unroll
                    for (int e = 0; e < 16; ++e) { o1[e] = (x1[e] * cs[e] - x2[e] * sn[e]) * sc; o2[e] = (x2[e] * cs[e] + x1[e] * sn[e]) * sc; }
#pragma unroll
                    for (int e8 = 0; e8 < 2; ++e8) {
                        v4u o; o.x = cvt_pk_bf16(o1[8 * e8], o1[8 * e8 + 1]); o.y = cvt_pk_bf16(o1[8 * e8 + 2], o1[8 * e8 + 3]); o.z = cvt_pk_bf16(o1[8 * e8 + 4], o1[8 * e8 + 5]); o.w = cvt_pk_bf16(o1[8 * e8 + 6], o1[8 * e8 + 7]);
                        *(v4u*)(QA + (size_t)tok * D + qcol + 8 * e8) = o;
                        v4u p; p.x = cvt_pk_bf16(o2[8 * e8], o2[8 * e8 + 1]); p.y = cvt_pk_bf16(o2[8 * e8 + 2], o2[8 * e8 + 3]); p.z = cvt_pk_bf16(o2[8 * e8 + 4], o2[8 * e8 + 5]); p.w = cvt_pk_bf16(o2[8 * e8 + 6], o2[8 * e8 + 7]);
                        *(v4u*)(QA + (size_t)tok * D + qcol + 128 + 8 * e8) = p; }
                    if (part == 1) {
#pragma unroll
                        for (int e = 0; e < 16; e += 2) {
                            *(LAS unsigned*)(KW + lrow * P5_KP + d0 + e) = cvt_pk_bf16(o1[e] * gwt, o1[e + 1] * gwt);
                            *(LAS unsigned*)(KW + lrow * P5_KP + 128 + d0 + e) = cvt_pk_bf16(o2[e] * gwt, o2[e + 1] * gwt); }
                    }
                }
            }
        }
        }
        bf16x8 bfr[4][4];
        { const bf16* vt = VT + (size_t)(mh * 512 + 64 * F.wave + fr) * S + c * 128 + fq * 8;
#pragma unroll
            for (int i = 0; i < 4; ++i)
#pragma unroll
                for (int kk = 0; kk < 4; ++kk) bfr[i][kk] = __builtin_nontemporal_load((const bf16x8*)(vt + (size_t)(i * 16) * S + 32 * kk)); }
        LDS_WAIT(); __syncthreads();
        if (mh < 4 && tu < 256) {
            float rs = 0.f;
#pragma unroll 16
            for (int r = 0; r < 128; ++r) rs += bf2f(KW[r * P5_KP + tu]);
            ((float*)(F.ws + WS_NPREV))[(size_t)(mh * 64 + c) * 256 + tu] = rs;
        }
        bf16* up = U + ((size_t)(mh * 64 + c) * 512 + 64 * F.wave + fr) * 256 + 4 * fq;
#pragma unroll 1
        for (int qd = 0; qd < 4; ++qd) {
            f32x4 acc[4][4];
#pragma unroll
            for (int i = 0; i < 4; ++i)
#pragma unroll
                for (int nn = 0; nn < 4; ++nn) acc[i][nn] = (f32x4){0.f, 0.f, 0.f, 0.f};
#pragma unroll
            for (int nn = 0; nn < 4; ++nn) {
                const LAS bf16* kc = KW + (8 * fq) * P5_KP + 64 * qd + 16 * nn + fr;
#pragma unroll
                for (int kk = 0; kk < 4; ++kk) {
                    bf16x8 af;
#pragma unroll
                    for (int j = 0; j < 8; ++j) af[j] = (short)kc[(32 * kk + j) * P5_KP];
#pragma unroll
                    for (int i = 0; i < 4; ++i) acc[i][nn] = __builtin_amdgcn_mfma_f32_16x16x32_bf16(af, bfr[i][kk], acc[i][nn], 0, 0, 0);
                }
            }
#pragma unroll
            for (int i = 0; i < 4; ++i)
#pragma unroll
                for (int nn = 0; nn < 4; ++nn) { const f32x4 v = acc[i][nn]; v2u o; o.x = cvt_pk_bf16(v[0], v[1]); o.y = cvt_pk_bf16(v[2], v[3]);
                    *(v2u*)(up + (size_t)(i * 16) * 256 + 64 * qd + 16 * nn) = o; }
        }
        __syncthreads();
    }
}

__device__ __forceinline__ float chunk_decay(Frame& F, int mh, int c) {
    if (mh < 4) { const float* MArr = (const float*)(F.ws + WS_MARR) + mh * S; const float mp = c > 0 ? MArr[c * 128 - 1] : 0.f; return __expf(mp - MArr[c * 128 + 127]); }
    return __expf(128.0f * logf(1.0f - exp2f(-5.0f - (float)(mh - 4))));
}
__device__ __forceinline__ void p7_scan(Frame& F) {
    int tz_ = threadIdx.x; asm volatile("" : "+v"(tz_)); const int tid_ = tz_, lane_ = tz_ & 63;
    bf16* U = (bf16*)(F.ws + WS_U);
    const int gid = (F.vcu * NWAVES + F.wave) * 64 + lane_, NT = F.G * NWAVES * 64;
    for (int e = gid; e < 8 * 16384; e += NT) {
        const int mh = e >> 14, rest = e & 16383;
        bf16* p = U + (size_t)(mh * 64) * 131072 + (size_t)rest * 8;
        float st[8];
#pragma unroll
        for (int q = 0; q < 8; ++q) st[q] = 0.f;
#pragma unroll 4
        for (int c = 0; c < 64; ++c) {
            const v4u u = __builtin_nontemporal_load((const v4u*)(p + (size_t)c * 131072));
            v4u o; o.x = cvt_pk_bf16(st[0], st[1]); o.y = cvt_pk_bf16(st[2], st[3]); o.z = cvt_pk_bf16(st[4], st[5]); o.w = cvt_pk_bf16(st[6], st[7]);
            *(v4u*)(p + (size_t)c * 131072) = o;
            const float d = chunk_decay(F, mh, c);
            st[0] = d * st[0] + bf_lo(u.x); st[1] = d * st[1] + bf_hi(u.x); st[2] = d * st[2] + bf_lo(u.y); st[3] = d * st[3] + bf_hi(u.y);
            st[4] = d * st[4] + bf_lo(u.z); st[5] = d * st[5] + bf_hi(u.z); st[6] = d * st[6] + bf_lo(u.w); st[7] = d * st[7] + bf_hi(u.w);
        }
    }
    if (gid < 1024) {
        const int head = gid >> 8, dk = gid & 255; float sn = 0.f;
        float* np = (float*)(F.ws + WS_NPREV) + (size_t)(head * 64) * 256 + dk;
        for (int c = 0; c < 64; ++c) { const float rs = np[c * 256]; np[c * 256] = sn; sn = chunk_decay(F, head, c) * sn + rs; }
    }
}

constexpr int P8_KP = 264, P8_VP = 136;
constexpr int P8_KS_OFF = 0, P8_PB_OFF = 128 * P8_KP * 2, P8_PB_BYTES = 64 * P8_KP * 2;
static_assert(P8_PB_OFF + 2 * P8_PB_BYTES <= MISC_OFF, "P8 LDS map");
__device__ __forceinline__ void p8_outputs(Frame& F, const Args& a) {
    int tz_ = threadIdx.x; asm volatile("" : "+v"(tz_)); const int tid_ = tz_, lane_ = tz_ & 63;
    const bf16* QA = (const bf16*)(F.ws + WS_QA); const bf16* VT = (const bf16*)(F.ws + WS_VT); const bf16* U = (const bf16*)(F.ws + WS_U); const bf16* proj = (const bf16*)(F.ws + WS_R1);
    const int slab = F.wave;
    LAS unsigned char* KS = F.lds + P8_KS_OFF;
    for (int unit = F.vcu; unit < 512; unit += F.G) {
        int tu = tid_; asm volatile("" : "+v"(tu)); const int fr = tu & 15, fq = (tu & 63) >> 4;
        const int mh = unit >> 6, c = unit & 63, mixer = mh >> 2, head = mh & 3;
        const int j0 = slab * 16 + fr, tok = c * 128 + j0;
        const bf16* ctg = U + (size_t)(mh * 64 + c) * 131072;
        const bf16* vtg = VT + (size_t)(mh * 512) * S + c * 128;
        const int p_first = c > 0 ? 0 : 8;
        {
            const bf16* kg = QA + (size_t)(c * 128) * D + (mixer ? 3072 : 1024) + head * 256;
            v4u kr[8];
#pragma unroll
            for (int i = 0; i < 8; ++i) { const int idx = tu + 512 * i; kr[i] = *(const v4u*)(kg + (size_t)(idx >> 5) * D + (idx & 31) * 8); }
            v4u pr[4];
            if (c > 0) {
#pragma unroll
                for (int i = 0; i < 4; ++i) { const int idx = tu + 512 * i; pr[i] = *(const v4u*)(ctg + (size_t)(idx >> 5) * 256 + (idx & 31) * 8); }
            } else {
#pragma unroll
                for (int i = 0; i < 2; ++i) { const int idx = tu + 512 * i; pr[i] = *(const v4u*)(vtg + (size_t)(idx >> 4) * S + (idx & 15) * 8); }
            }
#pragma unroll
            for (int i = 0; i < 8; ++i) { const int idx = tu + 512 * i; *(LAS v4u*)(KS + (idx >> 5) * (P8_KP * 2) + (idx & 31) * 16) = kr[i]; }
            LAS unsigned char* pb = F.lds + P8_PB_OFF;
            if (c > 0) {
#pragma unroll
                for (int i = 0; i < 4; ++i) { const int idx = tu + 512 * i; *(LAS v4u*)(pb + (idx >> 5) * (P8_KP * 2) + (idx & 31) * 16) = pr[i]; }
            } else {
#pragma unroll
                for (int i = 0; i < 2; ++i) { const int idx = tu + 512 * i; *(LAS v4u*)(pb + (idx >> 4) * (P8_VP * 2) + (idx & 15) * 16) = pr[i]; }
            }
        }
        bf16x8 qf[8];
        { const bf16* qrow = QA + (size_t)tok * D + (mixer ? 2048 : 0) + head * 256 + fq * 8;
#pragma unroll
            for (int kk = 0; kk < 8; ++kk) qf[kk] = *(const bf16x8*)(qrow + 32 * kk); }
        LDS_WAIT(); __syncthreads();
        f32x4 sacc[8];
#pragma unroll
        for (int sb = 0; sb < 8; ++sb) sacc[sb] = (f32x4){0.f, 0.f, 0.f, 0.f};
        { const LAS unsigned char* kb = KS + fr * (P8_KP * 2) + fq * 16;
#pragma unroll
            for (int sb = 0; sb < 8; ++sb) if (sb <= slab) {
                bf16x8 af[8];
#pragma unroll
                for (int kk = 0; kk < 8; ++kk) af[kk] = *(const LAS bf16x8*)(kb + (16 * sb) * (P8_KP * 2) + 64 * kk);
#pragma unroll
                for (int kk = 0; kk < 8; ++kk) sacc[sb] = __builtin_amdgcn_mfma_f32_16x16x32_bf16(af[kk], qf[kk], sacc[sb], 0, 0, 0);
            } }
        float winter, psum = 0.f, Mt = 0.f;
        if (mixer == 0) {
            const float* aArr = (const float*)(F.ws + WS_AARR) + head * S + c * 128; const float* MArr = (const float*)(F.ws + WS_MARR) + head * S;
            Mt = MArr[tok]; const float mp = c > 0 ? MArr[c * 128 - 1] : 0.f; winter = __expf(mp - Mt);
#pragma unroll
            for (int sb = 0; sb < 8; ++sb) { const f32x4 av = *(const f32x4*)(aArr + 16 * sb + 4 * fq);
#pragma unroll
                for (int j = 0; j < 4; ++j) { const int kp = 16 * sb + 4 * fq + j; const float w = kp <= j0 ? __expf(fminf(av[j] - Mt, 0.f)) : 0.f; sacc[sb][j] *= w; psum += sacc[sb][j]; } }
        } else {
            const float lg = logf(1.0f - exp2f(-5.0f - (float)head));
            winter = __expf(lg * (float)(j0 + 1));
#pragma unroll
            for (int sb = 0; sb < 8; ++sb)
#pragma unroll
                for (int j = 0; j < 4; ++j) { const int kp = 16 * sb + 4 * fq + j; const float w = kp <= j0 ? __expf(lg * (float)(j0 - kp)) : 0.f; sacc[sb][j] *= w; }
        }
        bf16x8 pf[4];
#pragma unroll
        for (int ks = 0; ks < 4; ++ks) { v4u w; w.x = cvt_pk_bf16(sacc[2 * ks][0], sacc[2 * ks][1]); w.y = cvt_pk_bf16(sacc[2 * ks][2], sacc[2 * ks][3]);
            w.z = cvt_pk_bf16(sacc[2 * ks + 1][0], sacc[2 * ks + 1][1]); w.w = cvt_pk_bf16(sacc[2 * ks + 1][2], sacc[2 * ks + 1][3]); pf[ks] = __builtin_bit_cast(bf16x8, w); }
        float qn = 0.f;
        if (mixer == 0) {
            if (c > 0) { const float* np = (const float*)(F.ws + WS_NPREV) + (size_t)(head * 64 + c) * 256 + 8 * fq;
#pragma unroll
                for (int kk = 0; kk < 8; ++kk) { const f32x4 n0 = *(const f32x4*)(np + 32 * kk), n1 = *(const f32x4*)(np + 32 * kk + 4); const v4u qw = __builtin_bit_cast(v4u, qf[kk]);
                    qn += (bf_lo(qw.x) * n0.x + bf_hi(qw.x) * n0.y) + (bf_lo(qw.y) * n0.z + bf_hi(qw.y) * n0.w) + (bf_lo(qw.z) * n1.x + bf_hi(qw.z) * n1.y) + (bf_lo(qw.w) * n1.z + bf_hi(qw.w) * n1.w); } }
        }
        f32x4 acc[32];
#pragma unroll
        for (int n = 0; n < 32; ++n) acc[n] = (f32x4){0.f, 0.f, 0.f, 0.f};
#pragma unroll
        for (int p = 0; p < 16; ++p) {
            if (p >= p_first) {
                int tp = tid_; asm volatile("" : "+v"(tp));
                const int tfr = tp & 15, tfq = (tp & 63) >> 4;
                v4u pr[4];
                if (p + 1 < 8) {
#pragma unroll
                    for (int i = 0; i < 4; ++i) { const int idx = tp + 512 * i; pr[i] = __builtin_nontemporal_load((const v4u*)(ctg + (size_t)(64 * (p + 1) + (idx >> 5)) * 256 + (idx & 31) * 8)); }
                } else if (p + 1 < 16) {
#pragma unroll
                    for (int i = 0; i < 2; ++i) { const int idx = tp + 512 * i; pr[i] = __builtin_nontemporal_load((const v4u*)(vtg + (size_t)(64 * (p + 1 - 8) + (idx >> 4)) * S + (idx & 15) * 8)); }
                }
                const LAS unsigned char* pb = F.lds + P8_PB_OFF + (p & 1) * P8_PB_BYTES;
                if (p < 8) {
                    const LAS unsigned char* cb = pb + tfr * (P8_KP * 2) + tfq * 16;
#pragma unroll
                    for (int nn = 0; nn < 4; ++nn) {
                        bf16x8 af[8];
#pragma unroll
                        for (int kk = 0; kk < 8; ++kk) af[kk] = *(const LAS bf16x8*)(cb + (16 * nn) * (P8_KP * 2) + 64 * kk);
#pragma unroll
                        for (int kk = 0; kk < 8; ++kk) acc[4 * p + nn] = __builtin_amdgcn_mfma_f32_16x16x32_bf16(af[kk], qf[kk], acc[4 * p + nn], 0, 0, 0);
                    }
                } else {
                    if (p == 8) {
#pragma unroll
                        for (int n = 0; n < 32; ++n) acc[n] = acc[n] * winter;
                    }
                    const LAS unsigned char* vb = pb + tfr * (P8_VP * 2) + tfq * 8;
#pragma unroll
                    for (int nn = 0; nn < 4; ++nn) {
#pragma unroll
                        for (int ks = 0; ks < 4; ++ks) if (2 * ks <= slab) {
                            const v2u lo = *(const LAS v2u*)(vb + (16 * nn) * (P8_VP * 2) + 64 * ks), hi = *(const LAS v2u*)(vb + (16 * nn) * (P8_VP * 2) + 64 * ks + 32);
                            v4u w; w.x = lo.x; w.y = lo.y; w.z = hi.x; w.w = hi.y;
                            acc[4 * (p - 8) + nn] = __builtin_amdgcn_mfma_f32_16x16x32_bf16(__builtin_bit_cast(bf16x8, w), pf[ks], acc[4 * (p - 8) + nn], 0, 0, 0);
                        }
                    }
                }
                if (p + 1 < 16) {
                    LAS unsigned char* nb = F.lds + P8_PB_OFF + ((p + 1) & 1) * P8_PB_BYTES;
                    if (p + 1 < 8) {
#pragma unroll
                        for (int i = 0; i < 4; ++i) { const int idx = tp + 512 * i; *(LAS v4u*)(nb + (idx >> 5) * (P8_KP * 2) + (idx & 31) * 16) = pr[i]; }
                    } else {
#pragma unroll
                        for (int i = 0; i < 2; ++i) { const int idx = tp + 512 * i; *(LAS v4u*)(nb + (idx >> 4) * (P8_VP * 2) + (idx & 15) * 16) = pr[i]; }
                    }
                    LDS_WAIT(); __syncthreads();
                }
            }
        }
        if (mixer == 0) {
            qn += __shfl_xor(qn, 16); qn += __shfl_xor(qn, 32);
            psum += __shfl_xor(psum, 16); psum += __shfl_xor(psum, 32);
            const float den = psum + winter * qn;
            const float Bm = ((const float*)(F.ws + WS_BMARR))[head * S + tok];
            const float inv = 1.0f / fmaxf(fabsf(den), __expf(-Bm));
#pragma unroll
            for (int n = 0; n < 32; ++n) acc[n] = acc[n] * inv;
        }
        float s1 = 0.f;
#pragma unroll
        for (int n = 0; n < 32; ++n) s1 += (acc[n][0] + acc[n][1]) + (acc[n][2] + acc[n][3]);
        s1 += __shfl_xor(s1, 16); s1 += __shfl_xor(s1, 32);
        const float mean = s1 * (1.0f / 512.0f); float s2 = 0.f;
#pragma unroll
        for (int n = 0; n < 32; ++n) { acc[n] = acc[n] - mean; s2 += (acc[n][0] * acc[n][0] + acc[n][1] * acc[n][1]) + (acc[n][2] * acc[n][2] + acc[n][3] * acc[n][3]); }
        s2 += __shfl_xor(s2, 16); s2 += __shfl_xor(s2, 32);
        const float rstd = 1.0f / sqrtf(s2 * (1.0f / 512.0f) + HEAD_EPS);
        int te = tid_; asm volatile("" : "+v"(te)); const int efq = (te & 63) >> 4, etok = c * 128 + slab * 16 + (te & 15);
        const float* gain = (const float*)a.in[mixer ? 12 : 11] + head * 512 + 4 * efq;
        const bf16* gp = proj + (size_t)etok * NP + (mixer ? 4096 : 6144) + head * 512 + 4 * efq;
        bf16* yp = (bf16*)(F.ws + WS_Y) + (size_t)etok * D + mixer * 2048 + head * 512 + 4 * efq;
#pragma unroll
        for (int n = 0; n < 32; ++n) {
            const f32x4 gn = *(const f32x4*)(gain + 16 * n); const v2u gw2 = *(const v2u*)(gp + 16 * n);
            const float g0 = bf_lo(gw2.x), g1 = bf_hi(gw2.x), g2 = bf_lo(gw2.y), g3 = bf_hi(gw2.y);
            float y0 = acc[n][0] * rstd * gn.x, y1 = acc[n][1] * rstd * gn.y, y2 = acc[n][2] * rstd * gn.z, y3 = acc[n][3] * rstd * gn.w;
            if (mixer == 0) { y0 *= fast_sigmoid(g0); y1 *= fast_sigmoid(g1); y2 *= fast_sigmoid(g2); y3 *= fast_sigmoid(g3); }
            else { y0 *= fast_silu(g0); y1 *= fast_silu(g1); y2 *= fast_silu(g2); y3 *= fast_silu(g3); }
            v2u o; o.x = cvt_pk_bf16(y0, y1); o.y = cvt_pk_bf16(y2, y3);
            *(v2u*)(yp + 16 * n) = o;
        }
        __syncthreads();
    }
}

__global__ void __launch_bounds__(NWAVES * 64, 2) fwd_kernel(Args args) {
    extern __shared__ __attribute__((aligned(16))) unsigned char lds_raw[];
    Frame F;
    F.lds = (LAS unsigned char*)lds_raw; F.ws = args.ws; F.in = nullptr;
    F.tid = threadIdx.x; F.lane = F.tid & 63; F.wave = __builtin_amdgcn_readfirstlane(F.tid >> 6);
    F.G = gridDim.x; { const int bx = blockIdx.x; F.vcu = (F.G % 8 == 0) ? (bx % 8) * (F.G / 8) + bx / 8 : bx; }
    volatile LAS unsigned* MISC = (volatile LAS unsigned*)(F.lds + MISC_OFF);
    for (int u = F.tid; u < 128; u += NWAVES * 64) MISC[u] = 0u;
    __syncthreads();
    const int lo = args.ph_lo, hi = args.ph_hi;
    XcdBarrier bar; bar.bar = (unsigned*)(F.ws + WS_CTL) + CW_BAR; bar.x = 0; bar.st = nullptr;
    if (hi - lo > 1) bar = xcd_barrier_post((unsigned*)(F.ws + WS_CTL) + CW_BAR, MISC + 8);
#ifndef PH_MASK
#define PH_MASK 0xFFFF
#endif
#define IN(k) (((PH_MASK >> (k)) & 1) && lo <= (k) && (k) < hi)
#define SEAM(k) do { if (IN(k) && IN((k) + 1)) xcd_barrier(bar); } while (0)
    LAS unsigned char* ring = F.lds;
    bf16* const XB = (bf16*)(F.ws + WS_XB); bf16* const R1 = (bf16*)(F.ws + WS_R1); float* const T = (float*)(F.ws + WS_T);
    float* const HF = (float*)(F.ws + WS_HF); bf16* const HB = (bf16*)(F.ws + WS_HB);

#ifndef REP_MASK
#define REP_MASK 0
#endif
#define PHASE(k, ...) do { if (IN(k)) { __VA_ARGS__ if ((REP_MASK >> (k)) & 1) { xcd_barrier(bar); __VA_ARGS__ } } SEAM(k); } while (0)
    PHASE(0, { p0_convert(F, args); });
    PHASE(1, { pg8::Gemm g{XB, (const bf16*)(F.ws + WS_WGU1), S, 2 * FF, D}; pg8::StaticOrder so; so.init(S, 2 * FF, F.G, (int)blockIdx.x);
        pg8::EpiSwiGLU E{R1, FF}; pg8::gemm_phase<pg8::EpiSwiGLU, pg8::StaticOrder, true, true>(ring, g, so, E);
        if (F.G == 256 && (int)blockIdx.x >= 192) p0_tiles(F, args, T_WD1_LO, T_WD1_HI, ((int)blockIdx.x - 192) * NWAVES + F.wave, 64 * NWAVES); });
    PHASE(2, { pg8::Gemm g{R1, (const bf16*)(F.ws + WS_WD1), S, D, FF}; pg8::StaticOrder so; so.init(S, D, F.G, (int)blockIdx.x);
        pg8::EpiResid E{(const float*)args.in[0], T, D, ALPHA, 0.5f, (float*)(F.ws + WS_PART)}; pg8::gemm_phase<pg8::EpiResid, pg8::StaticOrder, true, true>(ring, g, so, E); });
    PHASE(3, { ln_phase<1>(F, T, (const float*)args.in[5], (const float*)args.in[6], nullptr, HB, (const float*)args.in[8]); });
    PHASE(4, {
        if (blockIdx.x < 4) gate_scan(F, (int)blockIdx.x);
        { pg8::Gemm g{HB, (const bf16*)(F.ws + WS_WIN), S, 6144, D}; pg8::StaticOrder so; so.init(S, 6144, F.G, (int)blockIdx.x);
          pg8::EpiPlainBf16 E{R1, NP}; pg8::gemm_phase<pg8::EpiPlainBf16, pg8::StaticOrder, true, true>(ring, g, so, E); }
        { pg8::Gemm g{(const bf16*)(F.ws + WS_H8), (const bf16*)(F.ws + WS_W8), S, 10240, D / 2}; pg8::StaticOrder so; so.init(S, 10240, F.G, (int)blockIdx.x);
          pg8::EpiPlainBf16 E{R1 + 6144, NP}; pg8::gemm_phase<pg8::EpiPlainBf16, pg8::StaticOrder, true, true, false, true>(ring, g, so, E); }
        { pg8::Gemm g{(const bf16*)(F.ws + WS_WIN) + (size_t)NP * D, HB, 4096, S, D}; pg8::StaticOrder so; so.init(4096, S, F.G, (int)blockIdx.x);
          pg8::EpiPlainBf16 E{(bf16*)(F.ws + WS_VT), S}; pg8::gemm_phase<pg8::EpiPlainBf16, pg8::StaticOrder, true, true>(ring, g, so, E); }
    });
    PHASE(5, { p5_states(F, args); });
    if (IN(6)) { p7_scan(F); } SEAM(6);
    PHASE(7, { p8_outputs(F, args); });
    PHASE(8, { pg8::Gemm g{(const bf16*)(F.ws + WS_Y), (const bf16*)(F.ws + WS_WPM), S, D, D}; pg8::StaticOrder so; so.init(S, D, F.G, (int)blockIdx.x);
        pg8::EpiMerged E{(bf16*)(F.ws + WS_MRG), R1 + 8192, R1 + 12288, NP, D}; pg8::gemm_phase<pg8::EpiMerged, pg8::StaticOrder, true, true, true>(ring, g, so, E); });
    PHASE(9, { pg8::Gemm g{(const bf16*)(F.ws + WS_MRG), (const bf16*)(F.ws + WS_WO), S, D, D}; pg8::StaticOrder so; so.init(S, D, F.G, (int)blockIdx.x);
        typedef pg8::EpiResidLN<WS_T, WS_HF, WS_STATS, WS_PART> EpiA; EpiA E{F.ws, (const float*)args.in[5], (const float*)args.in[6], 1.0f}; pg8::gemm_phase<EpiA, pg8::StaticOrder, true, true>(ring, g, so, E); });
    PHASE(10, { ln_phase<2>(F, HF, (const float*)args.in[16], (const float*)args.in[17], nullptr, HB, nullptr); });
    PHASE(11, { pg8::Gemm g{HB, (const bf16*)(F.ws + WS_WGU2), S, 2 * FF, D}; pg8::StaticOrder so; so.init(S, 2 * FF, F.G, (int)blockIdx.x);
        pg8::EpiSwiGLU E{R1, FF}; pg8::gemm_phase<pg8::EpiSwiGLU, pg8::StaticOrder, true, true>(ring, g, so, E);
        if (F.G == 256 && (int)blockIdx.x >= 192) p0_tiles(F, args, T_LATE, N_TILES, ((int)blockIdx.x - 192) * NWAVES + F.wave, 64 * NWAVES); });
    PHASE(12, { pg8::Gemm g{R1, (const bf16*)(F.ws + WS_WD2), S, D, FF}; pg8::StaticOrder so; so.init(S, D, F.G, (int)blockIdx.x);
        typedef pg8::EpiResidLN<WS_HF, WS_T, WS_STATS, WS_PART> EpiB; EpiB E{F.ws, (const float*)args.in[16], (const float*)args.in[17], 0.5f}; pg8::gemm_phase<EpiB, pg8::StaticOrder, true, true>(ring, g, so, E); });
    PHASE(13, { ln_phase<3>(F, T, (const float*)args.in[21], (const float*)args.in[22], args.out, nullptr, nullptr); });
#undef PHASE
#ifdef DBG_STOP
    if (lo == 100) {
        const size_t gt = (size_t)blockIdx.x * 512 + threadIdx.x, NT = (size_t)gridDim.x * 512;
        if (DBG_BF16) { const bf16* src = (const bf16*)(F.ws + (size_t)DBG_OFF_MIB * MiB); for (size_t i = gt; i < (size_t)S * D; i += NT) args.out[i] = i < (size_t)DBG_N ? bf2f(src[i]) : 0.f; }
        else { const float* src = (const float*)(F.ws + (size_t)DBG_OFF_MIB * MiB); for (size_t i = gt; i < (size_t)S * D; i += NT) args.out[i] = src[i]; }
    }
#endif
#undef IN
#undef SEAM
}

extern "C" void kernel_launch(void* const* d_in, const int* in_sizes, int n_in, void* d_out, int out_size, void* d_ws, size_t ws_size, hipStream_t stream) {
    static int grid = 0;
    if (grid == 0) {
        if (n_in != 23 || out_size != S * D || ws_size < WS_END2) { fprintf(stderr, "kernel_launch: unexpected problem (n_in %d out %d ws %zu need %zu)\n", n_in, out_size, ws_size, (size_t)WS_END2); grid = -1; return; }
        int dev = 0, cus = 0, per_cu = 0;
        if (hipGetDevice(&dev) != hipSuccess || hipDeviceGetAttribute(&cus, hipDeviceAttributeMultiprocessorCount, dev) != hipSuccess) { grid = -1; return; }
        if (hipFuncSetAttribute((const void*)fwd_kernel, hipFuncAttributeMaxDynamicSharedMemorySize, LDS_BYTES) != hipSuccess) { fprintf(stderr, "kernel_launch: hipFuncSetAttribute failed\n"); grid = -1; return; }
        if (hipOccupancyMaxActiveBlocksPerMultiprocessor(&per_cu, (const void*)fwd_kernel, NWAVES * 64, LDS_BYTES) != hipSuccess || per_cu < 1) { fprintf(stderr, "kernel_launch: occupancy query says %d\n", per_cu); }
        (void)hipGetLastError();
        grid = cus;
    }
    if (grid < 0) return;
    (void)hipMemsetAsync((char*)d_ws + WS_CTL, 0, CTL_ZERO_BYTES, stream);
#ifdef DBG_NANFILL
    (void)hipMemsetAsync((char*)d_ws + CTL_ZERO_BYTES, 0xFF, WS_END2 - CTL_ZERO_BYTES, stream);
#endif
    Args a{};
    for (int i = 0; i < 23; ++i) a.in[i] = d_in[i];
    a.out = (float*)d_out; a.ws = (unsigned char*)d_ws;
#if MK_ONE_LAUNCH
    a.ph_lo = 0; a.ph_hi = NPH;
    hipLaunchKernelGGL(fwd_kernel, dim3(grid), dim3(NWAVES * 64), LDS_BYTES, stream, a);
#else
#ifdef DBG_STOP
    for (int p = 0; p <= DBG_STOP; ++p) { a.ph_lo = p; a.ph_hi = p + 1; hipLaunchKernelGGL(fwd_kernel, dim3(grid), dim3(NWAVES * 64), LDS_BYTES, stream, a); }
    a.ph_lo = 100; a.ph_hi = 101; hipLaunchKernelGGL(fwd_kernel, dim3(grid), dim3(NWAVES * 64), LDS_BYTES, stream, a);
#else
    for (int p = 0; p < NPH; ++p) { a.ph_lo = p; a.ph_hi = p + 1; hipLaunchKernelGGL(fwd_kernel, dim3(grid), dim3(NWAVES * 64), LDS_BYTES, stream, a); }
#endif
#endif
}
```

```cpp
#include <hip/hip_runtime.h>
#include <cstdio>
#include <cstdint>
namespace pg8 {
#define PG8_LAS __attribute__((address_space(3)))
typedef unsigned short bf16_t;
typedef short bf16x8 __attribute__((ext_vector_type(8)));
typedef float f32x4 __attribute__((ext_vector_type(4)));
typedef unsigned u32x4 __attribute__((ext_vector_type(4)));
typedef int v4i32 __attribute__((ext_vector_type(4)));
typedef int v8i32 __attribute__((ext_vector_type(8)));
constexpr int BM = 256, BK = 64, HALF = 128, HTB = HALF * BK * 2  , STAGE_BYTES = 8 * HTB, NXCD = 8, WGM = 8;

__host__ __device__ __forceinline__ int lds_byte(int r, int c) { const int st = (r >> 4) * 2 + (c >> 5), rr = r & 15, cc = c & 31, ob = rr * 64 + cc * 2; return st * 1024 + (ob ^ (((ob >> 9) & 1) << 5)); }
__host__ __device__ __forceinline__ void stage_rc(int b, int& R, int& C) { const int st = b / 1024, sb = b % 1024, swz = sb ^ (((sb >> 9) & 1) << 5); R = (st >> 1) * 16 + swz / 64; C = (st & 1) * 32 + (swz % 64) / 2; }
__host__ __device__ __forceinline__ int perm32(int rho) { const int n = rho >> 4, i = rho & 15; return 8 * (i >> 2) + 4 * n + (i & 3); }

struct Unit { int pm, pn; };
struct Gemm { const bf16_t* A; const bf16_t* Bt; int M, N, K; };

struct StaticOrder {
    int nM, nN, nwg, G, c;
    __host__ __device__ void init(int M, int N, int G_, int c_) { nM = M / BM; nN = N / BM; nwg = nM * nN; G = G_; c = c_; }
    __host__ __device__ bool next(int i, Unit& u) const {
        const long L = (long)i * G + c; if (L >= nwg) return false;
        int wgid = (int)L; { const int q = nwg / NXCD, r = nwg % NXCD, xcd = wgid % NXCD, off = wgid / NXCD; wgid = (xcd < r ? xcd * (q + 1) : r * (q + 1) + (xcd - r) * q) + off; }
        const int nig = WGM * nN, gid = wgid / nig, fm = gid * WGM, gsz = (nM - fm) < WGM ? (nM - fm) : WGM;
        u.pm = fm + ((wgid % nig) % gsz); u.pn = (wgid % nig) / gsz; return true;
    }
    __device__ __forceinline__ void a_ready(const Unit&) const {}
    __device__ __forceinline__ void done(const Unit&) const {}
};
typedef float f32x2c __attribute__((ext_vector_type(2)));
typedef __bf16 bf16x2c __attribute__((ext_vector_type(2)));
__device__ __forceinline__ unsigned cvt_pk_bf16(float lo, float hi) { const f32x2c v = {lo, hi}; const bf16x2c r = __builtin_convertvector(v, bf16x2c); return __builtin_bit_cast(unsigned, r); }
typedef float f32x2 __attribute__((ext_vector_type(2)));
__device__ __forceinline__ float fast_sigmoid(float x) { return __builtin_amdgcn_rcpf(1.0f + __builtin_amdgcn_exp2f(-1.4426950408889634f * x)); }
__device__ __forceinline__ float bf_lo(unsigned w) { return __uint_as_float(w << 16); }
__device__ __forceinline__ float bf_hi(unsigned w) { return __uint_as_float(w & 0xffff0000u); }

struct EpiPlainBf16 {
    static constexpr bool PERM = true, AFTER_DRAIN = false;
    bf16_t* O; int ldc;
    __device__ __forceinline__ void operator()(const f32x4 (&acc)[2][2][4][2], const Unit& u, int wr, int wc, int fr, int fq) const {
        const int row0 = u.pm * BM + wr * 64 + fr; const int col0 = u.pn * BM + wc * 32 + 8 * fq;
#pragma unroll
        for (int ai = 0; ai < 2; ++ai)
#pragma unroll
            for (int m = 0; m < 4; ++m) { bf16_t* rowp = O + (size_t)(row0 + ai * HALF + m * 16) * ldc + col0;
#pragma unroll
                for (int bj = 0; bj < 2; ++bj) { const f32x4 v0 = acc[ai][bj][m][0], v1 = acc[ai][bj][m][1];
                    u32x4 w; w.x = cvt_pk_bf16(v0[0], v0[1]); w.y = cvt_pk_bf16(v0[2], v0[3]); w.z = cvt_pk_bf16(v1[0], v1[1]); w.w = cvt_pk_bf16(v1[2], v1[3]);
                    *(u32x4*)(rowp + bj * HALF) = w; } }
    }
};
struct EpiSwiGLU {
    static constexpr bool PERM = true, AFTER_DRAIN = false;
    bf16_t* H; int ldh;
    __device__ __forceinline__ void operator()(const f32x4 (&acc)[2][2][4][2], const Unit& u, int wr, int wc, int fr, int fq) const {
        const int row0 = u.pm * BM + wr * 64 + fr; const int col0 = u.pn * HALF + wc * 32 + 8 * fq;
#pragma unroll
        for (int ai = 0; ai < 2; ++ai)
#pragma unroll
            for (int m = 0; m < 4; ++m) { bf16_t* rowp = H + (size_t)(row0 + ai * HALF + m * 16) * ldh + col0;
                float o[8];
#pragma unroll
                for (int n = 0; n < 2; ++n)
#pragma unroll
                    for (int j = 0; j < 4; ++j) { const float g = acc[ai][0][m][n][j], up = acc[ai][1][m][n][j]; o[4 * n + j] = g * fast_sigmoid(g) * up; }
                u32x4 w; w.x = cvt_pk_bf16(o[0], o[1]); w.y = cvt_pk_bf16(o[2], o[3]); w.z = cvt_pk_bf16(o[4], o[5]); w.w = cvt_pk_bf16(o[6], o[7]);
                *(u32x4*)rowp = w; }
    }
};
struct EpiResid {
    static constexpr bool PERM = false, AFTER_DRAIN = false;
    const float* base; float* T; int ldc; float alpha, s; float* part;
    __device__ __forceinline__ void operator()(const f32x4 (&acc)[2][2][4][2], const Unit& u, int wr, int wc, int fr, int fq) const {
        const int row0 = u.pm * BM + wr * 64 + fr, col0 = u.pn * BM + wc * 32 + 4 * fq;
#pragma unroll
        for (int ai = 0; ai < 2; ++ai)
#pragma unroll
            for (int m = 0; m < 4; ++m) { const int row = row0 + ai * HALF + m * 16; const size_t off = (size_t)row * ldc + col0; float ps = 0.f, pq = 0.f;
#pragma unroll
                for (int bj = 0; bj < 2; ++bj)
#pragma unroll
                    for (int n = 0; n < 2; ++n) { const f32x4 b = *(const f32x4*)(base + off + bj * HALF + n * 16); const f32x4 o = b * alpha + acc[ai][bj][m][n] * s; *(f32x4*)(T + off + bj * HALF + n * 16) = o;
                        ps += (o[0] + o[1]) + (o[2] + o[3]); pq += (o[0] * o[0] + o[1] * o[1]) + (o[2] * o[2] + o[3] * o[3]); }
                ps += __shfl_xor(ps, 16); ps += __shfl_xor(ps, 32); pq += __shfl_xor(pq, 16); pq += __shfl_xor(pq, 32);
                if (fq == 0) { f32x2 pv; pv.x = ps; pv.y = pq; *(f32x2*)(part + ((size_t)row * 64 + u.pn * 4 + wc) * 2) = pv; } }
    }
};
template <size_t TIN_OFF, size_t TOUT_OFF, size_t STATS_OFF, size_t PART_OFF> struct EpiResidLN {
    static constexpr bool PERM = false, AFTER_DRAIN = false;
    unsigned char* ws; const float* lw; const float* lb; float s;
    __device__ __forceinline__ void operator()(const f32x4 (&acc)[2][2][4][2], const Unit& u, int, int, int, int) const {
        int tz = threadIdx.x; asm volatile("" : "+v"(tz));
        const int wid = tz >> 6, wr = wid >> 2, wc = wid & 3, fr = tz & 15, fq = (tz & 63) >> 4;
        const int row0 = u.pm * BM + wr * 64 + fr, col0 = u.pn * BM + wc * 32 + 4 * fq;
        constexpr int ldc = 4096; constexpr float alpha = 1.1892071150027210667f;
        const float* Tin = (const float*)(ws + TIN_OFF); float* Tout = (float*)(ws + TOUT_OFF); const float* stats = (const float*)(ws + STATS_OFF); float* part = (float*)(ws + PART_OFF);
        f32x4 wv[2][2], bv[2][2];
#pragma unroll
        for (int bj = 0; bj < 2; ++bj)
#pragma unroll
            for (int n = 0; n < 2; ++n) { wv[bj][n] = *(const f32x4*)(lw + col0 + bj * HALF + n * 16) * alpha; bv[bj][n] = *(const f32x4*)(lb + col0 + bj * HALF + n * 16) * alpha; }
#pragma unroll
        for (int ai = 0; ai < 2; ++ai)
#pragma unroll
            for (int m = 0; m < 4; ++m) { const int row = row0 + ai * HALF + m * 16; const size_t off = (size_t)row * ldc + col0;
                const float mean = stats[2 * row], rstd = stats[2 * row + 1]; float ps = 0.f, pq = 0.f;
#pragma unroll
                for (int bj = 0; bj < 2; ++bj)
#pragma unroll
                    for (int n = 0; n < 2; ++n) { const f32x4 t = *(const f32x4*)(Tin + off + bj * HALF + n * 16);
                        const f32x4 o = ((t - mean) * rstd) * wv[bj][n] + bv[bj][n] + acc[ai][bj][m][n] * s; *(f32x4*)(Tout + off + bj * HALF + n * 16) = o;
                        ps += (o[0] + o[1]) + (o[2] + o[3]); pq += (o[0] * o[0] + o[1] * o[1]) + (o[2] * o[2] + o[3] * o[3]); }
                ps += __shfl_xor(ps, 16); ps += __shfl_xor(ps, 32); pq += __shfl_xor(pq, 16); pq += __shfl_xor(pq, 32);
                if (fq == 0) { f32x2 pv; pv.x = ps; pv.y = pq; *(f32x2*)(part + ((size_t)row * 64 + u.pn * 4 + wc) * 2) = pv; } }
    }
};
struct EpiMerged {
    static constexpr bool PERM = true, AFTER_DRAIN = false;
    bf16_t* O; const bf16_t* ga; const bf16_t* gb; int ldg, ldc;
    __device__ __forceinline__ void mid(f32x4 (&acc)[2][2][4][2], const Unit& u, int, int, int, int) const {
        int tz = threadIdx.x; asm volatile("" : "+v"(tz));
        const int wid = tz >> 6, wr = wid >> 2, wc = wid & 3, fr = tz & 15, fq = (tz & 63) >> 4;
        const int row0 = u.pm * BM + wr * 64 + fr; const int col0 = u.pn * BM + wc * 32 + 8 * fq;
#pragma unroll
        for (int ai = 0; ai < 2; ++ai)
#pragma unroll
            for (int m = 0; m < 4; ++m) { const int row = row0 + ai * HALF + m * 16;
#pragma unroll
                for (int bj = 0; bj < 2; ++bj) { const size_t off = (size_t)row * ldg + col0 + bj * HALF;
                    const u32x4 a = *(const u32x4*)(ga + off), b = *(const u32x4*)(gb + off);
                    const unsigned aw[4] = {a.x, a.y, a.z, a.w}, bw[4] = {b.x, b.y, b.z, b.w};
#pragma unroll
                    for (int h = 0; h < 4; ++h) {
                        const float ea0 = __builtin_amdgcn_exp2f(-1.4426950408889634f * bf_lo(aw[h])), ea1 = __builtin_amdgcn_exp2f(-1.4426950408889634f * bf_hi(aw[h]));
                        const float eb0 = __builtin_amdgcn_exp2f(-1.4426950408889634f * bf_lo(bw[h])), eb1 = __builtin_amdgcn_exp2f(-1.4426950408889634f * bf_hi(bw[h]));
                        acc[ai][bj][m][h >> 1][2 * (h & 1)] *= (1.0f + eb0) * __builtin_amdgcn_rcpf(1.0f + ea0);
                        acc[ai][bj][m][h >> 1][2 * (h & 1) + 1] *= (1.0f + eb1) * __builtin_amdgcn_rcpf(1.0f + ea1); }
                }
                asm volatile("" ::: "memory"); }
    }
    __device__ __forceinline__ void operator()(const f32x4 (&acc)[2][2][4][2], const Unit& u, int, int, int, int) const {
        int tz = threadIdx.x; asm volatile("" : "+v"(tz));
        const int wid = tz >> 6, wr = wid >> 2, wc = wid & 3, fr = tz & 15, fq = (tz & 63) >> 4;
        const int row0 = u.pm * BM + wr * 64 + fr; const int col0 = u.pn * BM + wc * 32 + 8 * fq;
#pragma unroll
        for (int ai = 0; ai < 2; ++ai)
#pragma unroll
            for (int m = 0; m < 4; ++m) { const int row = row0 + ai * HALF + m * 16;
#pragma unroll
                for (int bj = 0; bj < 2; ++bj) { const int col = col0 + bj * HALF;
                    const u32x4 g = *(const u32x4*)(gb + (size_t)row * ldg + col);
                    const f32x4 v0 = acc[ai][bj][m][0], v1 = acc[ai][bj][m][1];
                    u32x4 w;
                    w.x = cvt_pk_bf16(fast_sigmoid(bf_lo(g.x)) * v0[0], fast_sigmoid(bf_hi(g.x)) * v0[1]); w.y = cvt_pk_bf16(fast_sigmoid(bf_lo(g.y)) * v0[2], fast_sigmoid(bf_hi(g.y)) * v0[3]);
                    w.z = cvt_pk_bf16(fast_sigmoid(bf_lo(g.z)) * v1[0], fast_sigmoid(bf_hi(g.z)) * v1[1]); w.w = cvt_pk_bf16(fast_sigmoid(bf_lo(g.w)) * v1[2], fast_sigmoid(bf_hi(g.w)) * v1[3]);
                    *(u32x4*)(O + (size_t)row * ldc + col) = w; } }
    }
};

template <class Epi, class Sched, bool ALIGN_EPI = false, bool SP2 = false, bool MID = false, bool FP8 = false>
__device__ __forceinline__ void gemm_phase(PG8_LAS unsigned char* lds, const Gemm g, const Sched& S, const Epi& E) {
    const int tid = threadIdx.x, wid = __builtin_amdgcn_readfirstlane(tid >> 6), lane = tid & 63, wr = wid >> 2, wc = wid & 3, fr = lane & 15, fq = lane >> 4;
    const int K = g.K, nt = K / BK;
    unsigned voffA[2], voffB[2];
#pragma unroll
    for (int i = 0; i < 2; ++i) { int R, C; stage_rc(tid * 16 + i * 8192, R, C); const int Rb = Epi::PERM ? ((R & ~31) + perm32(R & 31)) : R;
        voffA[i] = (unsigned)(R * K + C) * 2u; voffB[i] = (unsigned)(Rb * K + C) * 2u; }
    const size_t kstep = (size_t)(BK * 2);
    const size_t hstep = (size_t)HALF * K * 2;
    const size_t tstep = 2 * hstep;
    const unsigned ldsw = (unsigned)wid * 1024u;
    const int aoff = lds_byte(wr * 64 + fr, fq * 8), boff = lds_byte(wc * 32 + fr, fq * 8);
#define PG8_SA(b, h) (((b) * 2 + (h)) * HTB)
#define PG8_SB(b, h) ((4 + (b) * 2 + (h)) * HTB)
#define PG8_STAGE(bufoff, gbase, voff) do { _Pragma("unroll") for (int _i = 0; _i < 2; ++_i) \
        __builtin_amdgcn_global_load_lds((const unsigned*)((const char*)(gbase) + (voff)[_i]), (PG8_LAS unsigned*)(lds + (bufoff) + ldsw + _i * 8192), 16, 0, 0); } while (0)
#define PG8_LDA(dst, b, h) do { if constexpr (FP8) { _Pragma("unroll") for (int m = 0; m < 4; ++m) dst##8[m] = __builtin_shufflevector(*(const PG8_LAS v4i32*)(lds + PG8_SA(b, h) + aoff + m * 2048), *(const PG8_LAS v4i32*)(lds + PG8_SA(b, h) + aoff + m * 2048 + 1024), 0, 1, 2, 3, 4, 5, 6, 7); } \
    else { _Pragma("unroll") for (int m = 0; m < 4; ++m) _Pragma("unroll") for (int k = 0; k < 2; ++k) dst[m][k] = *(const PG8_LAS bf16x8*)(lds + PG8_SA(b, h) + aoff + m * 2048 + k * 1024); } } while (0)
#define PG8_LDB(dst, b, h) do { if constexpr (FP8) { _Pragma("unroll") for (int n = 0; n < 2; ++n) dst##8[n] = __builtin_shufflevector(*(const PG8_LAS v4i32*)(lds + PG8_SB(b, h) + boff + n * 2048), *(const PG8_LAS v4i32*)(lds + PG8_SB(b, h) + boff + n * 2048 + 1024), 0, 1, 2, 3, 4, 5, 6, 7); } \
    else { _Pragma("unroll") for (int n = 0; n < 2; ++n) _Pragma("unroll") for (int k = 0; k < 2; ++k) dst[n][k] = *(const PG8_LAS bf16x8*)(lds + PG8_SB(b, h) + boff + n * 2048 + k * 1024); } } while (0)
#define PG8_MMA(ai, bj, At, Bt) do { __builtin_amdgcn_s_setprio(1); _Pragma("unroll") for (int m = 0; m < 4; ++m) _Pragma("unroll") for (int n = 0; n < 2; ++n) { \
        if constexpr (FP8) { asm volatile("v_mfma_scale_f32_16x16x128_f8f6f4 %0, %1, %2, %0, %3, %4 op_sel_hi:[0,0,0]" : "+v"(acc[ai][bj][m][n]) : "v"(Bt##8[n]), "v"(At##8[m]), "v"(scl_w), "v"(scl_a)); } \
        else { _Pragma("unroll") for (int k = 0; k < 2; ++k) acc[ai][bj][m][n] = __builtin_amdgcn_mfma_f32_16x16x32_bf16(Bt[n][k], At[m][k], acc[ai][bj][m][n], 0, 0, 0); } } \
        __builtin_amdgcn_s_setprio(0); } while (0)
#define PG8_WAIT_V(n) asm volatile("s_waitcnt vmcnt(" #n ")" ::: "memory")
#define PG8_WAIT_L(n) asm volatile("s_waitcnt lgkmcnt(" #n ")" ::: "memory")
#define PG8_BAR __builtin_amdgcn_s_barrier()
#define PG8_SCHED __builtin_amdgcn_sched_barrier(0)
    Unit cur, nxt; int ui = 0;
    if (!S.next(0, cur)) return;
    f32x4 acc[2][2][4][2];
#pragma unroll
    for (int a = 0; a < 2; ++a)
#pragma unroll
        for (int b = 0; b < 2; ++b)
#pragma unroll
            for (int m = 0; m < 4; ++m)
#pragma unroll
                for (int n = 0; n < 2; ++n) acc[a][b][m][n] = (f32x4){0.f, 0.f, 0.f, 0.f};
    bf16x8 At[4][2], B0[2][2], B1[2][2];
    const int scl_w = 0x79797979, scl_a = 0x7F7F7F7F;
    v8i32 At8[4], B08[2], B18[2];
    const char* cA = (const char*)g.A + (size_t)cur.pm * tstep; const char* cB = (const char*)g.Bt + (size_t)cur.pn * tstep;
    S.a_ready(cur);
    if constexpr (SP2) {
        PG8_STAGE(PG8_SB(0, 0), cB, voffB); PG8_STAGE(PG8_SB(0, 1), cB + hstep, voffB); PG8_STAGE(PG8_SA(0, 0), cA, voffA); PG8_STAGE(PG8_SA(0, 1), cA + hstep, voffA);
        if (wr == 1) PG8_BAR;
        PG8_WAIT_V(2); PG8_BAR;
        PG8_STAGE(PG8_SB(1, 0), cB + kstep, voffB); PG8_STAGE(PG8_SA(1, 0), cA + kstep, voffA); PG8_STAGE(PG8_SB(1, 1), cB + hstep + kstep, voffB);
        PG8_WAIT_V(6); PG8_BAR;
    } else {
        PG8_STAGE(PG8_SB(0, 0), cB, voffB); PG8_STAGE(PG8_SA(0, 0), cA, voffA); PG8_STAGE(PG8_SB(0, 1), cB + hstep, voffB); PG8_STAGE(PG8_SA(0, 1), cA + hstep, voffA);
        if (wr == 1) PG8_BAR;
        PG8_WAIT_V(4); PG8_BAR;
        PG8_STAGE(PG8_SB(1, 0), cB + kstep, voffB); PG8_STAGE(PG8_SA(1, 0), cA + kstep, voffA); PG8_STAGE(PG8_SB(1, 1), cB + hstep + kstep, voffB);
        PG8_WAIT_V(6); PG8_BAR;
    }
    for (;;) {
        const bool has_next = S.next(ui + 1, nxt);
        const char* nA = has_next ? (const char*)g.A + (size_t)nxt.pm * tstep : cA; const char* nB = has_next ? (const char*)g.Bt + (size_t)nxt.pn * tstep : cB;
        for (int hf = 0; hf < (MID ? 2 : 1); ++hf) {
        if constexpr (MID) { if (hf == 1) E.mid(acc, cur, wr, wc, fr, fq); }
        for (int t = MID ? hf * (nt >> 1) : 0; t < (MID ? (hf + 1) * (nt >> 1) : nt); t += 2) {
            const bool last = (t == nt - 2);
            const char* a1 = cA + (size_t)(t + 1) * kstep;
            const char* a2 = last ? nA : cA + (size_t)(t + 2) * kstep; const char* b2 = last ? nB : cB + (size_t)(t + 2) * kstep;
            const char* a3 = a2 + kstep; const char* b3 = b2 + kstep;
            if (last && has_next) S.a_ready(nxt);
            if constexpr (SP2) {
            PG8_LDB(B0, 0, 0); PG8_LDB(B1, 0, 1); PG8_SCHED; PG8_LDA(At, 0, 0); PG8_STAGE(PG8_SA(1, 1), a1 + hstep, voffA);
            PG8_WAIT_V(8); PG8_WAIT_L(0); PG8_BAR; PG8_MMA(0, 0, At, B0); PG8_MMA(0, 1, At, B1); PG8_BAR; PG8_SCHED;
            PG8_LDA(At, 0, 1); PG8_STAGE(PG8_SB(0, 0), b2, voffB); PG8_STAGE(PG8_SB(0, 1), b2 + hstep, voffB); PG8_STAGE(PG8_SA(0, 0), a2, voffA);
            PG8_WAIT_V(8); PG8_WAIT_L(0); PG8_BAR; PG8_MMA(1, 0, At, B0); PG8_MMA(1, 1, At, B1); PG8_BAR; PG8_SCHED;
            PG8_LDB(B0, 1, 0); PG8_LDB(B1, 1, 1); PG8_SCHED; PG8_LDA(At, 1, 0); PG8_STAGE(PG8_SA(0, 1), a2 + hstep, voffA);
            PG8_WAIT_V(8); PG8_WAIT_L(0); PG8_BAR; PG8_MMA(0, 0, At, B0); PG8_MMA(0, 1, At, B1); PG8_BAR; PG8_SCHED;
            PG8_LDA(At, 1, 1); PG8_STAGE(PG8_SB(1, 0), b3, voffB); PG8_STAGE(PG8_SB(1, 1), b3 + hstep, voffB); PG8_STAGE(PG8_SA(1, 0), a3, voffA);
            PG8_WAIT_V(8); PG8_WAIT_L(0); PG8_BAR; PG8_MMA(1, 0, At, B0); PG8_MMA(1, 1, At, B1); PG8_BAR; PG8_SCHED;
            } else {
            PG8_LDB(B0, 0, 0); PG8_SCHED; PG8_LDA(At, 0, 0); PG8_STAGE(PG8_SA(1, 1), a1 + hstep, voffA);
            PG8_WAIT_L(8); PG8_BAR; PG8_WAIT_L(0); PG8_MMA(0, 0, At, B0); PG8_BAR; PG8_SCHED;
            PG8_LDB(B1, 0, 1); PG8_STAGE(PG8_SB(0, 0), b2, voffB);
            PG8_BAR; PG8_WAIT_L(0); PG8_MMA(0, 1, At, B1); PG8_BAR;
            PG8_LDA(At, 0, 1); PG8_STAGE(PG8_SA(0, 0), a2, voffA);
            PG8_BAR; PG8_WAIT_L(0); PG8_MMA(1, 0, At, B0); PG8_BAR; PG8_SCHED;
            PG8_STAGE(PG8_SB(0, 1), b2 + hstep, voffB);
            PG8_WAIT_V(6); PG8_BAR; PG8_MMA(1, 1, At, B1); PG8_BAR;
            PG8_LDB(B0, 1, 0); PG8_SCHED; PG8_LDA(At, 1, 0); PG8_STAGE(PG8_SA(0, 1), a2 + hstep, voffA);
            PG8_WAIT_L(8); PG8_BAR; PG8_WAIT_L(0); PG8_MMA(0, 0, At, B0); PG8_BAR; PG8_SCHED;
            PG8_LDB(B1, 1, 1); PG8_STAGE(PG8_SB(1, 0), b3, voffB);
            PG8_BAR; PG8_WAIT_L(0); PG8_MMA(0, 1, At, B1); PG8_BAR;
            PG8_LDA(At, 1, 1); PG8_STAGE(PG8_SA(1, 0), a3, voffA);
            PG8_BAR; PG8_WAIT_L(0); PG8_MMA(1, 0, At, B0); PG8_BAR; PG8_SCHED;
            PG8_STAGE(PG8_SB(1, 1), b3 + hstep, voffB);
            PG8_WAIT_V(6); PG8_BAR; PG8_MMA(1, 1, At, B1); PG8_BAR;
            }
        }
        }
        if constexpr (FP8) asm volatile("s_nop 15\n\ts_nop 15\n\ts_nop 15" ::: "memory");
        if constexpr (ALIGN_EPI) { if (wr == 0) PG8_BAR; }
        if constexpr (!Epi::AFTER_DRAIN) { E(acc, cur, wr, wc, fr, fq); S.done(cur); }
        if (!has_next) break;
#pragma unroll
        for (int a = 0; a < 2; ++a)
#pragma unroll
            for (int b = 0; b < 2; ++b)
#pragma unroll
                for (int m = 0; m < 4; ++m)
#pragma unroll
                    for (int n = 0; n < 2; ++n) acc[a][b][m][n] = (f32x4){0.f, 0.f, 0.f, 0.f};
        cur = nxt; cA = nA; cB = nB; ++ui;
        if constexpr (ALIGN_EPI) { if (wr == 1) PG8_BAR; }
    }
    PG8_WAIT_V(0);
    if constexpr (!ALIGN_EPI) { if (wr == 0) PG8_BAR; }
    PG8_BAR;
    if constexpr (Epi::AFTER_DRAIN) { E.fused(acc, cur, wr, wc, fr, fq, lds, wid, lane); S.done(cur); }
#undef PG8_SA
#undef PG8_SB
#undef PG8_STAGE
#undef PG8_LDA
#undef PG8_LDB
#undef PG8_MMA
#undef PG8_WAIT_V
#undef PG8_WAIT_L
#undef PG8_BAR
#undef PG8_SCHED
}
}

constexpr int NWAVES = 8;
constexpr int S = 8192, D = 4096, FF = 11008, DIN = 20488, NP = 16384;
constexpr int NPH = 14;
#ifndef MK_ONE_LAUNCH
#define MK_ONE_LAUNCH 1
#endif
constexpr float ALPHA = 1.1892071150027210667f;
constexpr float LN_EPS = 1e-5f, HEAD_EPS = 1e-6f;

constexpr size_t MiB = 1u << 20, KiB = 1u << 10;
constexpr size_t WS_CTL = 0, CTL_ZERO_BYTES = 1 * MiB;
constexpr size_t WS_WIF = 1 * MiB;
constexpr size_t WS_GATES = WS_WIF + 128 * KiB;
constexpr size_t WS_AARR = WS_GATES + 256 * KiB;
constexpr size_t WS_MARR = WS_AARR + 128 * KiB;
constexpr size_t WS_BMARR = WS_MARR + 128 * KiB;
constexpr size_t WS_NPREV = WS_BMARR + 128 * KiB;
constexpr size_t WS_WGU1 = 4 * MiB;
constexpr size_t WS_WD1 = WS_WGU1 + 172 * MiB;
constexpr size_t WS_WIN = WS_WD1 + 86 * MiB;
constexpr size_t WS_WPM = WS_WIN + 160 * MiB;
constexpr size_t WS_WPR = WS_WPM + 16 * MiB;
constexpr size_t WS_WO = WS_WPR + 16 * MiB;
constexpr size_t WS_WGU2 = WS_WO + 32 * MiB;
constexpr size_t WS_WD2 = WS_WGU2 + 172 * MiB;
constexpr size_t WS_R1 = WS_WD2 + 86 * MiB;
constexpr size_t WS_T = WS_R1 + 256 * MiB;
constexpr size_t WS_HF = WS_T + 128 * MiB;
constexpr size_t WS_HB = WS_HF + 128 * MiB;
constexpr size_t WS_XB = WS_HB + 64 * MiB;
constexpr size_t WS_END = WS_XB + 64 * MiB;
constexpr size_t WS_VT = WS_WGU1;
constexpr size_t WS_U = WS_END;
constexpr size_t WS_END2 = WS_U + 128 * MiB;
constexpr size_t WS_QA = WS_WGU1 + 64 * MiB;
constexpr size_t WS_STATS = 2 * MiB;
constexpr size_t WS_PART = WS_WGU1 + 128 * MiB;
constexpr size_t WS_KTW = WS_T + 64 * MiB;
constexpr size_t WS_Y = WS_HB;
constexpr size_t WS_MRG = WS_XB;
constexpr size_t WS_H8 = WS_XB;
constexpr size_t WS_W8 = WS_WIN + (size_t)6144 * 4096 * 2;
constexpr int CW_BAR = 4096;

constexpr int LDS_BYTES = 147456;
constexpr int MISC_OFF = LDS_BYTES - 512;

#define GAS __attribute__((address_space(1)))
#define LAS __attribute__((address_space(3)))
typedef unsigned short bf16;
typedef unsigned v4u __attribute__((ext_vector_type(4)));
typedef unsigned v2u __attribute__((ext_vector_type(2)));
typedef float f32x4 __attribute__((ext_vector_type(4)));
typedef short bf16x8 __attribute__((ext_vector_type(8)));
typedef float f32x2q __attribute__((ext_vector_type(2)));
#define LDS_WAIT() asm volatile("s_waitcnt lgkmcnt(0)" ::: "memory")
#define VM_WAIT() asm volatile("s_waitcnt vmcnt(0)" ::: "memory")
using pg8::cvt_pk_bf16; using pg8::bf_lo; using pg8::bf_hi; using pg8::fast_sigmoid;

#define XB_TMO      128
#define XB_XCNT(j)  (256  + 64 * (j))
#define XB_XSUB(j)  (1280 + 64 * (j))
#define XB_XGEN(j)  (2304 + 64 * (j))
#define XB_TOP      3328
#define XB_TOPGEN   3392
#define XCD_BAR_WORDS 3456
#define XB_SPIN_CAP (1u << 22)

__device__ __forceinline__ unsigned xb_ld(unsigned* p)              { return __hip_atomic_load(p, __ATOMIC_RELAXED, __HIP_MEMORY_SCOPE_AGENT); }
__device__ __forceinline__ unsigned xb_add(unsigned* p, unsigned v) { return __hip_atomic_fetch_add(p, v, __ATOMIC_RELAXED, __HIP_MEMORY_SCOPE_AGENT); }
__device__ __forceinline__ unsigned xb_xcc_id() { return (unsigned)__builtin_amdgcn_s_getreg((3 << 11) | 20) & 0xFu; }
#define XB_SPIN(cond, bar) do { unsigned _sp = 0; while (cond) { __builtin_amdgcn_s_sleep(1); \
    if ((++_sp & 255u) == 0u) { if (xb_ld(&(bar)[XB_TMO])) break; if (_sp > XB_SPIN_CAP) { atomicAdd(&(bar)[XB_TMO], 1u); break; } } } } while (0)

struct XcdBarrier {
    unsigned* bar; unsigned x;
    volatile LAS unsigned* st;
};

__device__ __forceinline__ XcdBarrier xcd_barrier_post(unsigned* bar, volatile LAS unsigned* st) {
    XcdBarrier b; b.bar = bar; b.x = xb_xcc_id(); b.st = st;
    if (threadIdx.x == 0) (void)xb_add(&bar[XB_XCNT(b.x)], 1u);
    return b;
}
__device__ __forceinline__ void xcd_barrier_complete(unsigned* bar, unsigned x, unsigned& nloc, unsigned& nx) {
    const unsigned G = gridDim.x * gridDim.y * gridDim.z;
    unsigned sum, cnt, mine, sp = 0u;
    for (;;) {
        sum = 0u; cnt = 0u; mine = 0u;
#pragma unroll
        for (unsigned j = 0; j < 16; ++j) { const unsigned c = xb_ld(&bar[XB_XCNT(j)]); sum += c; cnt += (c > 0u) ? 1u : 0u; mine = (j == x) ? c : mine; }
        if (sum == G) break;
        __builtin_amdgcn_s_sleep(1);
        if ((++sp & 255u) == 0u) { if (xb_ld(&bar[XB_TMO])) break; if (sp > XB_SPIN_CAP) { atomicAdd(&bar[XB_TMO], 1u); break; } }
    }
    nloc = mine > 0u ? mine : 1u; nx = cnt > 0u ? cnt : 1u;
}

__device__ __forceinline__ void xcd_barrier(const XcdBarrier& b) {
    asm volatile("s_waitcnt vmcnt(0)" ::: "memory");
    __syncthreads();
    if (threadIdx.x == 0) {
        unsigned* bar = b.bar;
        __builtin_amdgcn_s_waitcnt(0);
        unsigned nloc = b.st[0], nx = b.st[1];
        if (nloc == 0u) { xcd_barrier_complete(bar, b.x, nloc, nx); b.st[0] = nloc; b.st[1] = nx; }
        const unsigned old = xb_add(&bar[XB_XSUB(b.x)], 1u);
        const unsigned gen = old / nloc;
        if (old + 1u == (gen + 1u) * nloc) {
            __builtin_amdgcn_fence(__ATOMIC_RELEASE, "agent");
            asm volatile("s_waitcnt vmcnt(0)" ::: "memory");
            const unsigned og = xb_add(&bar[XB_TOP], 1u);
            const unsigned tg = og / nx;
            if (og + 1u == (tg + 1u) * nx) xb_add(&bar[XB_TOPGEN], 1u);
            else XB_SPIN(xb_ld(&bar[XB_TOPGEN]) == tg, bar);
            __builtin_amdgcn_fence(__ATOMIC_ACQUIRE, "agent");
            xb_add(&bar[XB_XGEN(b.x)], 1u);
            asm volatile("s_waitcnt vmcnt(0)" ::: "memory");
        } else {
            XB_SPIN(xb_ld(&bar[XB_XGEN(b.x)]) == gen, bar);
            __builtin_amdgcn_fence(__ATOMIC_ACQUIRE, "agent");
            asm volatile("s_waitcnt vmcnt(0)" ::: "memory");
        }
    }
    __syncthreads();
}

__device__ __forceinline__ float wave_sum(float v) {
#pragma unroll
    for (int o = 1; o < 64; o <<= 1) v += __shfl_xor(v, o);
    return v;
}
__device__ __forceinline__ float bf2f(unsigned short b) { return __uint_as_float(((unsigned)b) << 16); }
__device__ __forceinline__ float fast_silu(float x) { return x * fast_sigmoid(x); }

struct Frame {
    LAS unsigned char* lds;
    unsigned char* ws;
    const void* const* in;
    int tid, lane, wave, vcu, G;
};

struct Seg { int in_idx, ldw, col0, ntn, ldt, row0, map, dst_mib, tile_end, koff; };
__constant__ Seg c_segs[16] = {
    { 2, FF, 0, 172, D, 0, 1, (int)(WS_WGU1 / MiB), 11008, 0},
    { 3, FF, 0, 172, D, 0, 2, (int)(WS_WGU1 / MiB), 22016, 0},
    { 4, D, 0, 64, FF, 0, 0, (int)(WS_WD1 / MiB), 33024, 0},
    { 7, DIN, 0, 32, D, 0, 0, (int)(WS_WIN / MiB), 35072, 0},
    { 7, DIN, 4096, 32, D, 0, 3, (int)(WS_WIN / MiB), 37120, 0},
    { 7, DIN, 6152, 32, D, 2048, 0, (int)(WS_WIN / MiB), 39168, 0},
    { 7, DIN, 10248, 32, D, 4096, 0, (int)(WS_WIN / MiB), 41216, 0},
    { 7, DIN, 12296, 128, D, 2048, 3, (int)(WS_WIN / MiB), 49408, 0},
    { 7, DIN, 2048, 32, D, 16384, 0, (int)(WS_WIN / MiB), 51456, 0},
    { 7, DIN, 8200, 32, D, 18432, 0, (int)(WS_WIN / MiB), 53504, 0},
    {13, D, 0, 64, D, 0, 0, (int)(WS_WPM / MiB), 55552, 0},
    {14, D, 0, 64, D, 0, 0, (int)(WS_WPM / MiB), 57600, 2048},
    {15, D, 0, 64, D, 0, 0, (int)(WS_WO / MiB), 61696, 0},
    {18, FF, 0, 172, D, 0, 1, (int)(WS_WGU2 / MiB), 72704, 0},
    {19, FF, 0, 172, D, 0, 2, (int)(WS_WGU2 / MiB), 83712, 0},
    {20, D, 0, 64, FF, 0, 0, (int)(WS_WD2 / MiB), 94720, 0},
};
constexpr int N_TILES = 94720;

struct Args { const void* in[23]; float* out; unsigned char* ws; int ph_lo, ph_hi; };

struct TileDesc { const float* p; bf16* d; int ldw, ldt, fp8; };
__device__ __forceinline__ TileDesc p0_decode(const Args& a, unsigned char* ws, int it, int lane) {
    int si = 0;
#pragma unroll
    for (int q = 0; q < 15; ++q) si += (it >= c_segs[q].tile_end) ? 1 : 0;
    const Seg sg = c_segs[si];
    const int t = it - (si ? c_segs[si - 1].tile_end : 0);
    const int kg = 4;
    const int g4 = t / (kg * sg.ntn), rem = t - g4 * kg * sg.ntn, nb = rem / kg, kb = kg * g4 + (rem - nb * kg);
    const int n0 = 64 * nb;
    int r0 = sg.row0 + n0;
    if (sg.map == 1 || sg.map == 2) r0 = (n0 >> 7) * 256 + (n0 & 127) + (sg.map == 2 ? 128 : 0);
    TileDesc td;
    td.ldw = sg.ldw; td.ldt = sg.ldt; td.fp8 = sg.map == 3;
    if (sg.map == 3) {
        td.p = (const float*)a.in[sg.in_idx] + (size_t)(64 * kb + 4 * (lane >> 4)) * sg.ldw + sg.col0 + n0 + 4 * (lane & 15);
        td.d = (bf16*)(ws + WS_W8 + (size_t)(sg.row0 + n0 + (lane >> 2)) * 4096 + 64 * kb + 16 * (lane & 3));
        return td;
    }
    td.p = (const float*)a.in[sg.in_idx] + (size_t)(64 * kb + 2 * (lane >> 4)) * sg.ldw + sg.col0 + n0 + 4 * (lane & 15);
    td.d = (bf16*)(ws + (size_t)sg.dst_mib * MiB) + (size_t)(r0 + (lane >> 3)) * sg.ldt + sg.koff + 64 * kb + 8 * (lane & 7);
    return td;
}
__device__ __forceinline__ void p0_load(const TileDesc& td, f32x4 (&v)[16]) {
    if (td.fp8) {
#pragma unroll
        for (int i = 0; i < 4; ++i)
#pragma unroll
            for (int e = 0; e < 4; ++e) v[4 * i + e] = __builtin_nontemporal_load((const f32x4*)(td.p + (size_t)(16 * i + e) * td.ldw));
        return;
    }
#pragma unroll
    for (int i = 0; i < 8; ++i) { v[2 * i] = __builtin_nontemporal_load((const f32x4*)(td.p + (size_t)(8 * i) * td.ldw)); v[2 * i + 1] = __builtin_nontemporal_load((const f32x4*)(td.p + (size_t)(8 * i + 1) * td.ldw)); }
}
__device__ __forceinline__ unsigned pack4_fp8(float a, float b, float c, float d) { int w = 0; w = __builtin_amdgcn_cvt_pk_fp8_f32(a, b, w, false); w = __builtin_amdgcn_cvt_pk_fp8_f32(c, d, w, true); return (unsigned)w; }
__device__ __forceinline__ void p0_store(const TileDesc& td, const f32x4 (&v)[16], LAS unsigned* scr, int lane) {
    const int q = lane & 15, r = lane >> 4;
    if (td.fp8) {
#pragma unroll
        for (int i = 0; i < 4; ++i) { LAS unsigned* s = scr + (4 * q) * 16 + 4 * (i ^ (q & 3)) + r;
            s[0] = pack4_fp8(v[4 * i].x * 64.f, v[4 * i + 1].x * 64.f, v[4 * i + 2].x * 64.f, v[4 * i + 3].x * 64.f);
            s[16] = pack4_fp8(v[4 * i].y * 64.f, v[4 * i + 1].y * 64.f, v[4 * i + 2].y * 64.f, v[4 * i + 3].y * 64.f);
            s[32] = pack4_fp8(v[4 * i].z * 64.f, v[4 * i + 1].z * 64.f, v[4 * i + 2].z * 64.f, v[4 * i + 3].z * 64.f);
            s[48] = pack4_fp8(v[4 * i].w * 64.f, v[4 * i + 1].w * 64.f, v[4 * i + 2].w * 64.f, v[4 * i + 3].w * 64.f); }
        LDS_WAIT();
        const int g = lane & 3;
#pragma unroll
        for (int j = 0; j < 4; ++j) { const int n = (lane >> 2) + 16 * j;
            const v4u o = *(const LAS v4u*)(scr + n * 16 + 4 * (g ^ ((n >> 2) & 3)));
            __builtin_nontemporal_store(o, (v4u*)((unsigned char*)td.d + (size_t)(16 * j) * 4096)); }
        LDS_WAIT();
        return;
    }
#pragma unroll
    for (int i = 0; i < 8; ++i) { LAS unsigned* s = scr + (4 * q) * 32 + 4 * (i ^ (q & 7)) + r;
        s[0] = cvt_pk_bf16(v[2 * i].x, v[2 * i + 1].x); s[32] = cvt_pk_bf16(v[2 * i].y, v[2 * i + 1].y); s[64] = cvt_pk_bf16(v[2 * i].z, v[2 * i + 1].z); s[96] = cvt_pk_bf16(v[2 * i].w, v[2 * i + 1].w); }
    LDS_WAIT();
    const int g = lane & 7;
#pragma unroll
    for (int j = 0; j < 8; ++j) { const int n = (lane >> 3) + 8 * j;
        const v4u o = *(const LAS v4u*)(scr + n * 32 + 4 * (g ^ ((n >> 2) & 7)));
        __builtin_nontemporal_store(o, (v4u*)(td.d + (size_t)(8 * j) * td.ldt)); }
    LDS_WAIT();
}

__device__ __forceinline__ void p0_tiles(Frame& F, const Args& a, int t_lo, int t_hi, int gw, int ngw) {
    int tz_ = threadIdx.x; asm volatile("" : "+v"(tz_)); const int lane_ = tz_ & 63;
    LAS unsigned* scr = (LAS unsigned*)(F.lds + F.wave * 8192);
    f32x4 va[16], vb[16], vc[16];
    TileDesc da, db, dc;
    const int it0 = t_lo + gw;
    da = p0_decode(a, F.ws, it0 < t_hi ? it0 : t_lo, lane_); db = da; dc = da;
    if (it0 < t_hi) p0_load(da, va);
    if (it0 + ngw < t_hi) { db = p0_decode(a, F.ws, it0 + ngw, lane_); p0_load(db, vb); }
    for (int it = it0; it < t_hi; it += 3 * ngw) {
        if (it + 2 * ngw < t_hi) { dc = p0_decode(a, F.ws, it + 2 * ngw, lane_); p0_load(dc, vc); }
        p0_store(da, va, scr, lane_);
        if (it + 3 * ngw < t_hi) { da = p0_decode(a, F.ws, it + 3 * ngw, lane_); p0_load(da, va); }
        if (it + ngw < t_hi) p0_store(db, vb, scr, lane_);
        if (it + 4 * ngw < t_hi) { db = p0_decode(a, F.ws, it + 4 * ngw, lane_); p0_load(db, vb); }
        if (it + 2 * ngw < t_hi) p0_store(dc, vc, scr, lane_);
    }
}
constexpr int T_WD1_LO = 22016, T_WD1_HI = 33024;
constexpr int T_LATE = 83712;
__device__ __forceinline__ void p0_convert(Frame& F, const Args& a) {
    int tz_ = threadIdx.x; asm volatile("" : "+v"(tz_)); const int lane_ = tz_ & 63;
    p0_tiles(F, a, 0, T_WD1_LO, F.vcu * NWAVES + F.wave, F.G * NWAVES);
    p0_tiles(F, a, F.G == 256 ? T_WD1_HI : T_WD1_LO, F.G == 256 ? T_LATE : N_TILES, F.vcu * NWAVES + F.wave, F.G * NWAVES);
    const int gt = (F.vcu * NWAVES + F.wave) * 64 + lane_, NGT = F.G * NWAVES * 64;
    if (gt < 8 * D) { const int g = gt >> 12, k = gt & (D - 1); ((float*)(F.ws + WS_WIF))[gt] = ((const float*)a.in[7])[(size_t)k * DIN + 6144 + g]; }
    const float* x = (const float*)a.in[0]; bf16* xb = (bf16*)(F.ws + WS_XB);
    for (size_t i = (size_t)gt * 8; i < (size_t)S * D; i += (size_t)NGT * 8) {
        const f32x4 u0 = *(const f32x4*)(x + i), u1 = *(const f32x4*)(x + i + 4);
        v4u o; o.x = cvt_pk_bf16(u0.x, u0.y); o.y = cvt_pk_bf16(u0.z, u0.w); o.z = cvt_pk_bf16(u1.x, u1.y); o.w = cvt_pk_bf16(u1.z, u1.w);
        *(v4u*)(xb + i) = o;
    }
}

template <int MODE> __device__ __forceinline__ void ln_phase(Frame& F, const float* __restrict__ T, const float* __restrict__ w, const float* __restrict__ b,
                                                             float* __restrict__ OF, bf16* __restrict__ OB, const float* __restrict__ if_bias) {
    int tz_ = threadIdx.x; asm volatile("" : "+v"(tz_)); const int tid_ = tz_, lane_ = tz_ & 63;
    if (MODE == 1) {
        const v4u* srcw = (const v4u*)(F.ws + WS_WIF); LAS v4u* dl = (LAS v4u*)F.lds;
        for (int i = tid_; i < 8192; i += NWAVES * 64) dl[i] = srcw[i];
        LDS_WAIT(); __syncthreads();
    }
    const int gw = F.vcu * NWAVES + F.wave, NGW = F.G * NWAVES;
    const f32x4* w4 = (const f32x4*)w + lane_; const f32x4* b4 = (const f32x4*)b + lane_;
    const LAS f32x4* wl = (const LAS f32x4*)F.lds + lane_;
    for (int row = gw; row < S; row += NGW) {
        const f32x4* xr = (const f32x4*)(T + (size_t)row * D) + lane_;
        float s, ss;
        { const f32x2q pv = ((const f32x2q*)(F.ws + WS_PART))[(size_t)row * 64 + lane_]; s = wave_sum(pv.x); ss = wave_sum(pv.y); }
        const float mean = s * (1.f / D);
        const float var = fmaxf(ss * (1.f / D) - mean * mean, 0.f);
        const float rstd = 1.f / sqrtf(var + LN_EPS);
        f32x4* of = (f32x4*)(OF + (size_t)row * D) + lane_;
        if (MODE != 3 && lane_ == 0) { float* st = (float*)(F.ws + WS_STATS) + 2 * row; st[0] = mean; st[1] = rstd; }
        v2u* ob = (v2u*)(OB + (size_t)row * D) + lane_;
        float g[8];
#pragma unroll
        for (int q = 0; q < 8; ++q) g[q] = 0.f;
        constexpr int LN_UNR = MODE == 1 ? 4 : 8;
#pragma unroll LN_UNR
        for (int j = 0; j < 16; ++j) {
            const f32x4 y = (xr[64 * j] - mean) * rstd * w4[64 * j] + b4[64 * j];
            if (MODE == 3) __builtin_nontemporal_store(y, of + 64 * j);
            if (MODE != 3) { v2u o; o.x = cvt_pk_bf16(y.x, y.y); o.y = cvt_pk_bf16(y.z, y.w); ob[64 * j] = o; }
            if (MODE == 1) ((unsigned*)(F.ws + WS_H8 + (size_t)row * D))[lane_ + 64 * j] = pack4_fp8(y.x, y.y, y.z, y.w);
            if (MODE == 1) {
#pragma unroll
                for (int q = 0; q < 8; ++q) { const f32x4 ww = wl[q * 1024 + 64 * j]; g[q] += (y.x * ww.x + y.y * ww.y) + (y.z * ww.z + y.w * ww.w); }
            }
        }
        if (MODE == 1) {
#pragma unroll
            for (int q = 0; q < 8; ++q) g[q] = wave_sum(g[q]);
            if (lane_ == 0) { float* go = (float*)(F.ws + WS_GATES) + (size_t)row * 8;
#pragma unroll
                for (int q = 0; q < 8; ++q) go[q] = g[q] + if_bias[q]; }
        }
    }
}

__device__ __forceinline__ float log_sigmoid(float x) { return fminf(x, 0.f) - log1pf(expf(-fabsf(x))); }
__device__ __forceinline__ void gate_scan(Frame& F, int head) {
    int tz_ = threadIdx.x; asm volatile("" : "+v"(tz_)); const int tid_ = tz_, lane_ = tz_ & 63;
    const float* gates = (const float*)(F.ws + WS_GATES);
    float* aArr = (float*)(F.ws + WS_AARR) + head * S; float* MArr = (float*)(F.ws + WS_MARR) + head * S; float* BmArr = (float*)(F.ws + WS_BMARR) + head * S;
    LAS float* sc = (LAS float*)F.lds;
    const int t0 = tid_ * 16;
    float lf[16], iv[16];
    float run = 0.f;
    {
        LAS float* gl = sc + 64;
        const f32x4* g4 = (const f32x4*)gates;
#pragma unroll 8
        for (int k = 0; k < 32; ++k) { const int q = tid_ + 512 * k; const f32x4 v = g4[q]; gl[(q & 1) * S + (q >> 1)] = v[head]; }
        LDS_WAIT(); __syncthreads();
#pragma unroll
        for (int j = 0; j < 16; ++j) { iv[j] = gl[t0 + j]; run += log_sigmoid(gl[S + t0 + j]); lf[j] = run; }
    }
    float incl = run;
#pragma unroll
    for (int o = 1; o < 64; o <<= 1) { const float u = __shfl_up(incl, o); if (lane_ >= o) incl += u; }
    if (lane_ == 63) sc[F.wave] = incl;
    LDS_WAIT(); __syncthreads();
    float woff = 0.f;
    for (int w = 0; w < F.wave; ++w) woff += sc[w];
    const float excl = woff + incl - run;
    float mx = -INFINITY;
#pragma unroll
    for (int j = 0; j < 16; ++j) { const float B = excl + lf[j]; const float av = iv[j] - B; mx = fmaxf(mx, av); aArr[t0 + j] = av; lf[j] = B; iv[j] = mx; }
    float im = mx;
#pragma unroll
    for (int o = 1; o < 64; o <<= 1) { const float u = __shfl_up(im, o); if (lane_ >= o) im = fmaxf(im, u); }
    if (lane_ == 63) sc[16 + F.wave] = im;
    LDS_WAIT(); __syncthreads();
    float wm = -INFINITY;
    for (int w = 0; w < F.wave; ++w) wm = fmaxf(wm, sc[16 + w]);
    float prev = __shfl_up(im, 1); if (lane_ == 0) prev = -INFINITY;
    const float em = fmaxf(wm, prev);
#pragma unroll
    for (int j = 0; j < 16; ++j) { const float M = fmaxf(0.f, fmaxf(em, iv[j])); MArr[t0 + j] = M; BmArr[t0 + j] = lf[j] + M; }
    __syncthreads();
}

constexpr int P5_KP = 258;
__device__ __forceinline__ void p5_states(Frame& F, const Args& a) {
    int tz_ = threadIdx.x; asm volatile("" : "+v"(tz_)); const int tid_ = tz_;
    const bf16* proj = (const bf16*)(F.ws + WS_R1); bf16* QA = (bf16*)(F.ws + WS_QA); const bf16* VT = (const bf16*)(F.ws + WS_VT); bf16* U = (bf16*)(F.ws + WS_U);
    const float* convw = (const float*)a.in[9]; const float* convb = (const float*)a.in[10]; const int* positions = (const int*)a.in[1];
    LAS bf16* KW = (LAS bf16*)F.lds;
    float invf[16];
#pragma unroll
    for (int e = 0; e < 16; ++e) invf[e] = exp2f(-(float)((tid_ & 7) * 16 + e) * (13.287712379549449f / 128.0f));
    for (int unit = F.vcu; unit < 512; unit += F.G) {
        int tu = tid_; asm volatile("" : "+v"(tu));
        const int tl = tu >> 3, cb = tu & 7, fr = tu & 15, fq = (tu & 63) >> 4;
        const int mh = unit >> 6, c = unit & 63;
        if (mh < 4) {
            const int head = mh, tg = tu >> 5, cq = tu & 31, t0 = c * 128 + tg * 8;
            float wkv[8];
            { const float* aA = (const float*)(F.ws + WS_AARR) + head * S + t0; const float Mend = ((const float*)(F.ws + WS_MARR))[head * S + c * 128 + 127];
                const f32x4 a0 = *(const f32x4*)aA, a1 = *(const f32x4*)(aA + 4);
                wkv[0] = __expf(a0.x - Mend); wkv[1] = __expf(a0.y - Mend); wkv[2] = __expf(a0.z - Mend); wkv[3] = __expf(a0.w - Mend);
                wkv[4] = __expf(a1.x - Mend); wkv[5] = __expf(a1.y - Mend); wkv[6] = __expf(a1.z - Mend); wkv[7] = __expf(a1.w - Mend); }
#pragma unroll
            for (int part = 0; part < 2; ++part) {
                const int col = part * 1024 + head * 256 + cq * 8;
                float wt[4][8], bb[8];
#pragma unroll
                for (int j = 0; j < 4; ++j) { const f32x4 w0 = *(const f32x4*)(convw + j * 2048 + col), w1 = *(const f32x4*)(convw + j * 2048 + col + 4);
                    wt[j][0] = w0.x; wt[j][1] = w0.y; wt[j][2] = w0.z; wt[j][3] = w0.w; wt[j][4] = w1.x; wt[j][5] = w1.y; wt[j][6] = w1.z; wt[j][7] = w1.w; }
                { const f32x4 b0 = *(const f32x4*)(convb + col), b1 = *(const f32x4*)(convb + col + 4); bb[0] = b0.x; bb[1] = b0.y; bb[2] = b0.z; bb[3] = b0.w; bb[4] = b1.x; bb[5] = b1.y; bb[6] = b1.z; bb[7] = b1.w; }
                v4u xr[11];
#pragma unroll
                for (int r = 0; r < 11; ++r) { const int tt = t0 - 3 + r; xr[r] = tt >= 0 ? *(const v4u*)(proj + (size_t)tt * NP + col) : (v4u){0u, 0u, 0u, 0u}; }
                const float sc = part == 0 ? 0.0625f : 1.0f;
#pragma unroll
                for (int tk = 0; tk < 8; ++tk) {
                    float acc[8];
#pragma unroll
                    for (int e = 0; e < 8; ++e) acc[e] = bb[e];
#pragma unroll
                    for (int j = 0; j < 4; ++j) { const v4u xv = xr[tk + j];
                        acc[0] += wt[j][0] * bf_lo(xv.x); acc[1] += wt[j][1] * bf_hi(xv.x); acc[2] += wt[j][2] * bf_lo(xv.y); acc[3] += wt[j][3] * bf_hi(xv.y);
                        acc[4] += wt[j][4] * bf_lo(xv.z); acc[5] += wt[j][5] * bf_hi(xv.z); acc[6] += wt[j][6] * bf_lo(xv.w); acc[7] += wt[j][7] * bf_hi(xv.w); }
#pragma unroll
                    for (int e = 0; e < 8; ++e) acc[e] = fast_silu(acc[e]) * sc;
                    v4u o; o.x = cvt_pk_bf16(acc[0], acc[1]); o.y = cvt_pk_bf16(acc[2], acc[3]); o.z = cvt_pk_bf16(acc[4], acc[5]); o.w = cvt_pk_bf16(acc[6], acc[7]);
                    *(v4u*)(QA + (size_t)(t0 + tk) * D + col) = o;
                    if (part == 1) { const float wk = wkv[tk]; LAS unsigned* kd = (LAS unsigned*)(KW + (tg * 8 + tk) * P5_KP + cq * 8);
                        kd[0] = cvt_pk_bf16(acc[0] * wk, acc[1] * wk); kd[1] = cvt_pk_bf16(acc[2] * wk, acc[3] * wk); kd[2] = cvt_pk_bf16(acc[4] * wk, acc[5] * wk); kd[3] = cvt_pk_bf16(acc[6] * wk, acc[7] * wk); }
                }
            }
        } else {
#pragma unroll 1
        for (int sub = 0; sub < 2; ++sub) {
            const int lrow = sub * 64 + tl, tok = c * 128 + lrow;
            {
                const int head = mh - 4, d0 = cb * 16;
                const float posf = (float)positions[tok];
                const float lg = logf(1.0f - exp2f(-5.0f - (float)head));
                const float gwt = __expf(lg * (float)(127 - (tok & 127)));
                float cs[16], sn[16];
#pragma unroll
                for (int e = 0; e < 16; ++e) {
                    const float inv = invf[e];
                    const float p = posf * inv, perr = fmaf(posf, inv, -p);
                    const float k = rintf(p * 0.15915494309189535f);
                    float r = fmaf(-k, 6.28125f, p); r += perr; r = fmaf(-k, 0.0019353071795864769f, r);
                    const float rev = r * 0.15915494309189535f;
                    cs[e] = __builtin_amdgcn_cosf(rev); sn[e] = __builtin_amdgcn_sinf(rev);
                }
#pragma unroll
                for (int part = 0; part < 2; ++part) {
                    const int pcol = 2048 + part * 1024 + head * 256 + d0, qcol = 2048 + part * 1024 + head * 256 + d0;
                    const v4u a0 = *(const v4u*)(proj + (size_t)tok * NP + pcol), a1 = *(const v4u*)(proj + (size_t)tok * NP + pcol + 8);
                    const v4u b0 = *(const v4u*)(proj + (size_t)tok * NP + pcol + 128), b1 = *(const v4u*)(proj + (size_t)tok * NP + pcol + 136);
                    float x1[16], x2[16];
                    x1[0] = bf_lo(a0.x); x1[1] = bf_hi(a0.x); x1[2] = bf_lo(a0.y); x1[3] = bf_hi(a0.y); x1[4] = bf_lo(a0.z); x1[5] = bf_hi(a0.z); x1[6] = bf_lo(a0.w); x1[7] = bf_hi(a0.w);
                    x1[8] = bf_lo(a1.x); x1[9] = bf_hi(a1.x); x1[10] = bf_lo(a1.y); x1[11] = bf_hi(a1.y); x1[12] = bf_lo(a1.z); x1[13] = bf_hi(a1.z); x1[14] = bf_lo(a1.w); x1[15] = bf_hi(a1.w);
                    x2[0] = bf_lo(b0.x); x2[1] = bf_hi(b0.x); x2[2] = bf_lo(b0.y); x2[3] = bf_hi(b0.y); x2[4] = bf_lo(b0.z); x2[5] = bf_hi(b0.z); x2[6] = bf_lo(b0.w); x2[7] = bf_hi(b0.w);
                    x2[8] = bf_lo(b1.x); x2[9] = bf_hi(b1.x); x2[10] = bf_lo(b1.y); x2[11] = bf_hi(b1.y); x2[12] = bf_lo(b1.z); x2[13] = bf_hi(b1.z); x2[14] = bf_lo(b1.w); x2[15] = bf_hi(b1.w);
                    const float sc = part == 1 ? 0.0625f : 1.0f;
                    float o1[16], o2[16];
#pragma unroll
                    for (int e = 0; e < 16; ++e) { o1[e] = (x1[e] * cs[e] - x2[e] * sn[e]) * sc; o2[e] = (x2[e] * cs[e] + x1[e] * sn[e]) * sc; }
#pragma unroll
                    for (int e8 = 0; e8 < 2; ++e8) {
                        v4u o; o.x = cvt_pk_bf16(o1[8 * e8], o1[8 * e8 + 1]); o.y = cvt_pk_bf16(o1[8 * e8 + 2], o1[8 * e8 + 3]); o.z = cvt_pk_bf16(o1[8 * e8 + 4], o1[8 * e8 + 5]); o.w = cvt_pk_bf16(o1[8 * e8 + 6], o1[8 * e8 + 7]);
                        *(v4u*)(QA + (size_t)tok * D + qcol + 8 * e8) = o;
                        v4u p; p.x = cvt_pk_bf16(o2[8 * e8], o2[8 * e8 + 1]); p.y = cvt_pk_bf16(o2[8 * e8 + 2], o2[8 * e8 + 3]); p.z = cvt_pk_bf16(o2[8 * e8 + 4], o2[8 * e8 + 5]); p.w = cvt_pk_bf16(o2[8 * e8 + 6], o2[8 * e8 + 7]);
                        *(v4u*)(QA + (size_t)tok * D + qcol + 128 + 8 * e8) = p; }
                    if (part == 1) {
#pragma unroll
                        for (int e = 0; e < 16; e += 2) {
                            *(LAS unsigned*)(KW + lrow * P5_KP + d0 + e) = cvt_pk_bf16(o1[e] * gwt, o1[e + 1] * gwt);
                            *(LAS unsigned*)(KW + lrow * P5_KP + 128 + d0 + e) = cvt_pk_bf16(o2[e] * gwt, o2[e + 1] * gwt); }
                    }
                }
            }
        }
        }
        bf16x8 bfr[4][4];
        { const bf16* vt = VT + (size_t)(mh * 512 + 64 * F.wave + fr) * S + c * 128 + fq * 8;
#pragma unroll
            for (int i = 0; i < 4; ++i)
#pragma unroll
                for (int kk = 0; kk < 4; ++kk) bfr[i][kk] = *(const bf16x8*)(vt + (size_t)(i * 16) * S + 32 * kk); }
        LDS_WAIT(); __syncthreads();
        if (mh < 4 && tu < 256) {
            float rs = 0.f;
#pragma unroll 16
            for (int r = 0; r < 128; ++r) rs += bf2f(KW[r * P5_KP + tu]);
            ((float*)(F.ws + WS_NPREV))[(size_t)(mh * 64 + c) * 256 + tu] = rs;
        }
        bf16* up = U + ((size_t)(mh * 64 + c) * 512 + 64 * F.wave + fr) * 256 + 4 * fq;
#pragma unroll 1
        for (int qd = 0; qd < 4; ++qd) {
            f32x4 acc[4][4];
#pragma unroll
            for (int i = 0; i < 4; ++i)
#pragma unroll
                for (int nn = 0; nn < 4; ++nn) acc[i][nn] = (f32x4){0.f, 0.f, 0.f, 0.f};
#pragma unroll
            for (int nn = 0; nn < 4; ++nn) {
                const LAS bf16* kc = KW + (8 * fq) * P5_KP + 64 * qd + 16 * nn + fr;
#pragma unroll
                for (int kk = 0; kk < 4; ++kk) {
                    bf16x8 af;
#pragma unroll
                    for (int j = 0; j < 8; ++j) af[j] = (short)kc[(32 * kk + j) * P5_KP];
#pragma unroll
                    for (int i = 0; i < 4; ++i) acc[i][nn] = __builtin_amdgcn_mfma_f32_16x16x32_bf16(af, bfr[i][kk], acc[i][nn], 0, 0, 0);
                }
            }
#pragma unroll
            for (int i = 0; i < 4; ++i)
#pragma unroll
                for (int nn = 0; nn < 4; ++nn) { const f32x4 v = acc[i][nn]; v2u o; o.x = cvt_pk_bf16(v[0], v[1]); o.y = cvt_pk_bf16(v[2], v[3]);
                    *(v2u*)(up + (size_t)(i * 16) * 256 + 64 * qd + 16 * nn) = o; }
        }
        __syncthreads();
    }
}

__device__ __forceinline__ float chunk_decay(Frame& F, int mh, int c) {
    if (mh < 4) { const float* MArr = (const float*)(F.ws + WS_MARR) + mh * S; const float mp = c > 0 ? MArr[c * 128 - 1] : 0.f; return __expf(mp - MArr[c * 128 + 127]); }
    return __expf(128.0f * logf(1.0f - exp2f(-5.0f - (float)(mh - 4))));
}
__device__ __forceinline__ void p7_scan(Frame& F) {
    int tz_ = threadIdx.x; asm volatile("" : "+v"(tz_)); const int tid_ = tz_, lane_ = tz_ & 63;
    bf16* U = (bf16*)(F.ws + WS_U);
    const int gid = (F.vcu * NWAVES + F.wave) * 64 + lane_, NT = F.G * NWAVES * 64;
    for (int e = gid; e < 8 * 16384; e += NT) {
        const int mh = e >> 14, rest = e & 16383;
        bf16* p = U + (size_t)(mh * 64) * 131072 + (size_t)rest * 8;
        float st[8];
#pragma unroll
        for (int q = 0; q < 8; ++q) st[q] = 0.f;
#pragma unroll 4
        for (int c = 0; c < 64; ++c) {
            const v4u u = *(const v4u*)(p + (size_t)c * 131072);
            v4u o; o.x = cvt_pk_bf16(st[0], st[1]); o.y = cvt_pk_bf16(st[2], st[3]); o.z = cvt_pk_bf16(st[4], st[5]); o.w = cvt_pk_bf16(st[6], st[7]);
            *(v4u*)(p + (size_t)c * 131072) = o;
            const float d = chunk_decay(F, mh, c);
            st[0] = d * st[0] + bf_lo(u.x); st[1] = d * st[1] + bf_hi(u.x); st[2] = d * st[2] + bf_lo(u.y); st[3] = d * st[3] + bf_hi(u.y);
            st[4] = d * st[4] + bf_lo(u.z); st[5] = d * st[5] + bf_hi(u.z); st[6] = d * st[6] + bf_lo(u.w); st[7] = d * st[7] + bf_hi(u.w);
        }
    }
    if (gid < 1024) {
        const int head = gid >> 8, dk = gid & 255; float sn = 0.f;
        float* np = (float*)(F.ws + WS_NPREV) + (size_t)(head * 64) * 256 + dk;
        for (int c = 0; c < 64; ++c) { const float rs = np[c * 256]; np[c * 256] = sn; sn = chunk_decay(F, head, c) * sn + rs; }
    }
}

constexpr int P8_KP = 264, P8_VP = 136;
constexpr int P8_KS_OFF = 0, P8_PB_OFF = 128 * P8_KP * 2, P8_PB_BYTES = 64 * P8_KP * 2;
static_assert(P8_PB_OFF + 2 * P8_PB_BYTES <= MISC_OFF, "P8 LDS map");
__device__ __forceinline__ void p8_outputs(Frame& F, const Args& a) {
    int tz_ = threadIdx.x; asm volatile("" : "+v"(tz_)); const int tid_ = tz_, lane_ = tz_ & 63;
    const bf16* QA = (const bf16*)(F.ws + WS_QA); const bf16* VT = (const bf16*)(F.ws + WS_VT); const bf16* U = (const bf16*)(F.ws + WS_U); const bf16* proj = (const bf16*)(F.ws + WS_R1);
    const int slab = F.wave;
    LAS unsigned char* KS = F.lds + P8_KS_OFF;
    for (int unit = F.vcu; unit < 512; unit += F.G) {
        int tu = tid_; asm volatile("" : "+v"(tu)); const int fr = tu & 15, fq = (tu & 63) >> 4;
        const int mh = unit >> 6, c = unit & 63, mixer = mh >> 2, head = mh & 3;
        const int j0 = slab * 16 + fr, tok = c * 128 + j0;
        const bf16* ctg = U + (size_t)(mh * 64 + c) * 131072;
        const bf16* vtg = VT + (size_t)(mh * 512) * S + c * 128;
        const int p_first = c > 0 ? 0 : 8;
        {
            const bf16* kg = QA + (size_t)(c * 128) * D + (mixer ? 3072 : 1024) + head * 256;
            v4u kr[8];
#pragma unroll
            for (int i = 0; i < 8; ++i) { const int idx = tu + 512 * i; kr[i] = *(const v4u*)(kg + (size_t)(idx >> 5) * D + (idx & 31) * 8); }
            v4u pr[4];
            if (c > 0) {
#pragma unroll
                for (int i = 0; i < 4; ++i) { const int idx = tu + 512 * i; pr[i] = *(const v4u*)(ctg + (size_t)(idx >> 5) * 256 + (idx & 31) * 8); }
            } else {
#pragma unroll
                for (int i = 0; i < 2; ++i) { const int idx = tu + 512 * i; pr[i] = *(const v4u*)(vtg + (size_t)(idx >> 4) * S + (idx & 15) * 8); }
            }
#pragma unroll
            for (int i = 0; i < 8; ++i) { const int idx = tu + 512 * i; *(LAS v4u*)(KS + (idx >> 5) * (P8_KP * 2) + (idx & 31) * 16) = kr[i]; }
            LAS unsigned char* pb = F.lds + P8_PB_OFF;
            if (c > 0) {
#pragma unroll
                for (int i = 0; i < 4; ++i) { const int idx = tu + 512 * i; *(LAS v4u*)(pb + (idx >> 5) * (P8_KP * 2) + (idx & 31) * 16) = pr[i]; }
            } else {
#pragma unroll
                for (int i = 0; i < 2; ++i) { const int idx = tu + 512 * i; *(LAS v4u*)(pb + (idx >> 4) * (P8_VP * 2) + (idx & 15) * 16) = pr[i]; }
            }
        }
        bf16x8 qf[8];
        { const bf16* qrow = QA + (size_t)tok * D + (mixer ? 2048 : 0) + head * 256 + fq * 8;
#pragma unroll
            for (int kk = 0; kk < 8; ++kk) qf[kk] = *(const bf16x8*)(qrow + 32 * kk); }
        LDS_WAIT(); __syncthreads();
        f32x4 sacc[8];
#pragma unroll
        for (int sb = 0; sb < 8; ++sb) sacc[sb] = (f32x4){0.f, 0.f, 0.f, 0.f};
        { const LAS unsigned char* kb = KS + fr * (P8_KP * 2) + fq * 16;
#pragma unroll
            for (int sb = 0; sb < 8; ++sb) if (sb <= slab) {
                bf16x8 af[8];
#pragma unroll
                for (int kk = 0; kk < 8; ++kk) af[kk] = *(const LAS bf16x8*)(kb + (16 * sb) * (P8_KP * 2) + 64 * kk);
#pragma unroll
                for (int kk = 0; kk < 8; ++kk) sacc[sb] = __builtin_amdgcn_mfma_f32_16x16x32_bf16(af[kk], qf[kk], sacc[sb], 0, 0, 0);
            } }
        float winter, psum = 0.f, Mt = 0.f;
        if (mixer == 0) {
            const float* aArr = (const float*)(F.ws + WS_AARR) + head * S + c * 128; const float* MArr = (const float*)(F.ws + WS_MARR) + head * S;
            Mt = MArr[tok]; const float mp = c > 0 ? MArr[c * 128 - 1] : 0.f; winter = __expf(mp - Mt);
#pragma unroll
            for (int sb = 0; sb < 8; ++sb) { const f32x4 av = *(const f32x4*)(aArr + 16 * sb + 4 * fq);
#pragma unroll
                for (int j = 0; j < 4; ++j) { const int kp = 16 * sb + 4 * fq + j; const float w = kp <= j0 ? __expf(fminf(av[j] - Mt, 0.f)) : 0.f; sacc[sb][j] *= w; psum += sacc[sb][j]; } }
        } else {
            const float lg = logf(1.0f - exp2f(-5.0f - (float)head));
            winter = __expf(lg * (float)(j0 + 1));
#pragma unroll
            for (int sb = 0; sb < 8; ++sb)
#pragma unroll
                for (int j = 0; j < 4; ++j) { const int kp = 16 * sb + 4 * fq + j; const float w = kp <= j0 ? __expf(lg * (float)(j0 - kp)) : 0.f; sacc[sb][j] *= w; }
        }
        bf16x8 pf[4];
#pragma unroll
        for (int ks = 0; ks < 4; ++ks) { v4u w; w.x = cvt_pk_bf16(sacc[2 * ks][0], sacc[2 * ks][1]); w.y = cvt_pk_bf16(sacc[2 * ks][2], sacc[2 * ks][3]);
            w.z = cvt_pk_bf16(sacc[2 * ks + 1][0], sacc[2 * ks + 1][1]); w.w = cvt_pk_bf16(sacc[2 * ks + 1][2], sacc[2 * ks + 1][3]); pf[ks] = __builtin_bit_cast(bf16x8, w); }
        float qn = 0.f;
        if (mixer == 0) {
            if (c > 0) { const float* np = (const float*)(F.ws + WS_NPREV) + (size_t)(head * 64 + c) * 256 + 8 * fq;
#pragma unroll
                for (int kk = 0; kk < 8; ++kk) { const f32x4 n0 = *(const f32x4*)(np + 32 * kk), n1 = *(const f32x4*)(np + 32 * kk + 4); const v4u qw = __builtin_bit_cast(v4u, qf[kk]);
                    qn += (bf_lo(qw.x) * n0.x + bf_hi(qw.x) * n0.y) + (bf_lo(qw.y) * n0.z + bf_hi(qw.y) * n0.w) + (bf_lo(qw.z) * n1.x + bf_hi(qw.z) * n1.y) + (bf_lo(qw.w) * n1.z + bf_hi(qw.w) * n1.w); } }
        }
        f32x4 acc[32];
#pragma unroll
        for (int n = 0; n < 32; ++n) acc[n] = (f32x4){0.f, 0.f, 0.f, 0.f};
#pragma unroll
        for (int p = 0; p < 16; ++p) {
            if (p >= p_first) {
                int tp = tid_; asm volatile("" : "+v"(tp));
                const int tfr = tp & 15, tfq = (tp & 63) >> 4;
                v4u pr[4];
                if (p + 1 < 8) {
#pragma unroll
                    for (int i = 0; i < 4; ++i) { const int idx = tp + 512 * i; pr[i] = *(const v4u*)(ctg + (size_t)(64 * (p + 1) + (idx >> 5)) * 256 + (idx & 31) * 8); }
                } else if (p + 1 < 16) {
#pragma unroll
                    for (int i = 0; i < 2; ++i) { const int idx = tp + 512 * i; pr[i] = *(const v4u*)(vtg + (size_t)(64 * (p + 1 - 8) + (idx >> 4)) * S + (idx & 15) * 8); }
                }
                const LAS unsigned char* pb = F.lds + P8_PB_OFF + (p & 1) * P8_PB_BYTES;
                if (p < 8) {
                    const LAS unsigned char* cb = pb + tfr * (P8_KP * 2) + tfq * 16;
#pragma unroll
                    for (int nn = 0; nn < 4; ++nn) {
                        bf16x8 af[8];
#pragma unroll
                        for (int kk = 0; kk < 8; ++kk) af[kk] = *(const LAS bf16x8*)(cb + (16 * nn) * (P8_KP * 2) + 64 * kk);
#pragma unroll
                        for (int kk = 0; kk < 8; ++kk) acc[4 * p + nn] = __builtin_amdgcn_mfma_f32_16x16x32_bf16(af[kk], qf[kk], acc[4 * p + nn], 0, 0, 0);
                    }
                } else {
                    if (p == 8) {
#pragma unroll
                        for (int n = 0; n < 32; ++n) acc[n] = acc[n] * winter;
                    }
                    const LAS unsigned char* vb = pb + tfr * (P8_VP * 2) + tfq * 8;
#pragma unroll
                    for (int nn = 0; nn < 4; ++nn) {
#pragma unroll
                        for (int ks = 0; ks < 4; ++ks) if (2 * ks <= slab) {
                            const v2u lo = *(const LAS v2u*)(vb + (16 * nn) * (P8_VP * 2) + 64 * ks), hi = *(const LAS v2u*)(vb + (16 * nn) * (P8_VP * 2) + 64 * ks + 32);
                            v4u w; w.x = lo.x; w.y = lo.y; w.z = hi.x; w.w = hi.y;
                            acc[4 * (p - 8) + nn] = __builtin_amdgcn_mfma_f32_16x16x32_bf16(__builtin_bit_cast(bf16x8, w), pf[ks], acc[4 * (p - 8) + nn], 0, 0, 0);
                        }
                    }
                }
                if (p + 1 < 16) {
                    LAS unsigned char* nb = F.lds + P8_PB_OFF + ((p + 1) & 1) * P8_PB_BYTES;
                    if (p + 1 < 8) {
#pragma unroll
                        for (int i = 0; i < 4; ++i) { const int idx = tp + 512 * i; *(LAS v4u*)(nb + (idx >> 5) * (P8_KP * 2) + (idx & 31) * 16) = pr[i]; }
                    } else {
#pragma unroll
                        for (int i = 0; i < 2; ++i) { const int idx = tp + 512 * i; *(LAS v4u*)(nb + (idx >> 4) * (P8_VP * 2) + (idx & 15) * 16) = pr[i]; }
                    }
                    LDS_WAIT(); __syncthreads();
                }
            }
        }
        if (mixer == 0) {
            qn += __shfl_xor(qn, 16); qn += __shfl_xor(qn, 32);
            psum += __shfl_xor(psum, 16); psum += __shfl_xor(psum, 32);
            const float den = psum + winter * qn;
            const float Bm = ((const float*)(F.ws + WS_BMARR))[head * S + tok];
            const float inv = 1.0f / fmaxf(fabsf(den), __expf(-Bm));
#pragma unroll
            for (int n = 0; n < 32; ++n) acc[n] = acc[n] * inv;
        }
        float s1 = 0.f;
#pragma unroll
        for (int n = 0; n < 32; ++n) s1 += (acc[n][0] + acc[n][1]) + (acc[n][2] + acc[n][3]);
        s1 += __shfl_xor(s1, 16); s1 += __shfl_xor(s1, 32);
        const float mean = s1 * (1.0f / 512.0f); float s2 = 0.f;
#pragma unroll
        for (int n = 0; n < 32; ++n) { acc[n] = acc[n] - mean; s2 += (acc[n][0] * acc[n][0] + acc[n][1] * acc[n][1]) + (acc[n][2] * acc[n][2] + acc[n][3] * acc[n][3]); }
        s2 += __shfl_xor(s2, 16); s2 += __shfl_xor(s2, 32);
        const float rstd = 1.0f / sqrtf(s2 * (1.0f / 512.0f) + HEAD_EPS);
        int te = tid_; asm volatile("" : "+v"(te)); const int efq = (te & 63) >> 4, etok = c * 128 + slab * 16 + (te & 15);
        const float* gain = (const float*)a.in[mixer ? 12 : 11] + head * 512 + 4 * efq;
        const bf16* gp = proj + (size_t)etok * NP + (mixer ? 4096 : 6144) + head * 512 + 4 * efq;
        bf16* yp = (bf16*)(F.ws + WS_Y) + (size_t)etok * D + mixer * 2048 + head * 512 + 4 * efq;
#pragma unroll
        for (int n = 0; n < 32; ++n) {
            const f32x4 gn = *(const f32x4*)(gain + 16 * n); const v2u gw2 = *(const v2u*)(gp + 16 * n);
            const float g0 = bf_lo(gw2.x), g1 = bf_hi(gw2.x), g2 = bf_lo(gw2.y), g3 = bf_hi(gw2.y);
            float y0 = acc[n][0] * rstd * gn.x, y1 = acc[n][1] * rstd * gn.y, y2 = acc[n][2] * rstd * gn.z, y3 = acc[n][3] * rstd * gn.w;
            if (mixer == 0) { y0 *= fast_sigmoid(g0); y1 *= fast_sigmoid(g1); y2 *= fast_sigmoid(g2); y3 *= fast_sigmoid(g3); }
            else { y0 *= fast_silu(g0); y1 *= fast_silu(g1); y2 *= fast_silu(g2); y3 *= fast_silu(g3); }
            v2u o; o.x = cvt_pk_bf16(y0, y1); o.y = cvt_pk_bf16(y2, y3);
            *(v2u*)(yp + 16 * n) = o;
        }
        __syncthreads();
    }
}

__global__ void __launch_bounds__(NWAVES * 64, 2) fwd_kernel(Args args) {
    extern __shared__ __attribute__((aligned(16))) unsigned char lds_raw[];
    Frame F;
    F.lds = (LAS unsigned char*)lds_raw; F.ws = args.ws; F.in = nullptr;
    F.tid = threadIdx.x; F.lane = F.tid & 63; F.wave = __builtin_amdgcn_readfirstlane(F.tid >> 6);
    F.G = gridDim.x; { const int bx = blockIdx.x; F.vcu = (F.G % 8 == 0) ? (bx % 8) * (F.G / 8) + bx / 8 : bx; }
    volatile LAS unsigned* MISC = (volatile LAS unsigned*)(F.lds + MISC_OFF);
    for (int u = F.tid; u < 128; u += NWAVES * 64) MISC[u] = 0u;
    __syncthreads();
    const int lo = args.ph_lo, hi = args.ph_hi;
    XcdBarrier bar; bar.bar = (unsigned*)(F.ws + WS_CTL) + CW_BAR; bar.x = 0; bar.st = nullptr;
    if (hi - lo > 1) bar = xcd_barrier_post((unsigned*)(F.ws + WS_CTL) + CW_BAR, MISC + 8);
#ifndef PH_MASK
#define PH_MASK 0xFFFF
#endif
#define IN(k) (((PH_MASK >> (k)) & 1) && lo <= (k) && (k) < hi)
#define SEAM(k) do { if (IN(k) && IN((k) + 1)) xcd_barrier(bar); } while (0)
    LAS unsigned char* ring = F.lds;
    bf16* const XB = (bf16*)(F.ws + WS_XB); bf16* const R1 = (bf16*)(F.ws + WS_R1); float* const T = (float*)(F.ws + WS_T);
    float* const HF = (float*)(F.ws + WS_HF); bf16* const HB = (bf16*)(F.ws + WS_HB);

#ifndef REP_MASK
#define REP_MASK 0
#endif
#define PHASE(k, ...) do { if (IN(k)) { __VA_ARGS__ if ((REP_MASK >> (k)) & 1) { xcd_barrier(bar); __VA_ARGS__ } } SEAM(k); } while (0)
    PHASE(0, { p0_convert(F, args); });
    PHASE(1, { pg8::Gemm g{XB, (const bf16*)(F.ws + WS_WGU1), S, 2 * FF, D}; pg8::StaticOrder so; so.init(S, 2 * FF, F.G, (int)blockIdx.x);
        pg8::EpiSwiGLU E{R1, FF}; pg8::gemm_phase<pg8::EpiSwiGLU, pg8::StaticOrder, true, true>(ring, g, so, E);
        if (F.G == 256 && (int)blockIdx.x >= 192) p0_tiles(F, args, T_WD1_LO, T_WD1_HI, ((int)blockIdx.x - 192) * NWAVES + F.wave, 64 * NWAVES); });
    PHASE(2, { pg8::Gemm g{R1, (const bf16*)(F.ws + WS_WD1), S, D, FF}; pg8::StaticOrder so; so.init(S, D, F.G, (int)blockIdx.x);
        pg8::EpiResid E{(const float*)args.in[0], T, D, ALPHA, 0.5f, (float*)(F.ws + WS_PART)}; pg8::gemm_phase<pg8::EpiResid, pg8::StaticOrder, true, true>(ring, g, so, E); });
    PHASE(3, { ln_phase<1>(F, T, (const float*)args.in[5], (const float*)args.in[6], nullptr, HB, (const float*)args.in[8]); });
    PHASE(4, {
        if (blockIdx.x < 4) gate_scan(F, (int)blockIdx.x);
        { pg8::Gemm g{HB, (const bf16*)(F.ws + WS_WIN), S, 6144, D}; pg8::StaticOrder so; so.init(S, 6144, F.G, (int)blockIdx.x);
          pg8::EpiPlainBf16 E{R1, NP}; pg8::gemm_phase<pg8::EpiPlainBf16, pg8::StaticOrder, true, true>(ring, g, so, E); }
        { pg8::Gemm g{(const bf16*)(F.ws + WS_H8), (const bf16*)(F.ws + WS_W8), S, 10240, D / 2}; pg8::StaticOrder so; so.init(S, 10240, F.G, (int)blockIdx.x);
          pg8::EpiPlainBf16 E{R1 + 6144, NP}; pg8::gemm_phase<pg8::EpiPlainBf16, pg8::StaticOrder, true, true, false, true>(ring, g, so, E); }
        { pg8::Gemm g{(const bf16*)(F.ws + WS_WIN) + (size_t)NP * D, HB, 4096, S, D}; pg8::StaticOrder so; so.init(4096, S, F.G, (int)blockIdx.x);
          pg8::EpiPlainBf16 E{(bf16*)(F.ws + WS_VT), S}; pg8::gemm_phase<pg8::EpiPlainBf16, pg8::StaticOrder, true, true>(ring, g, so, E); }
    });
    PHASE(5, { p5_states(F, args); });
    if (IN(6)) { p7_scan(F); } SEAM(6);
    PHASE(7, { p8_outputs(F, args); });
    PHASE(8, { pg8::Gemm g{(const bf16*)(F.ws + WS_Y), (const bf16*)(F.ws + WS_WPM), S, D, D}; pg8::StaticOrder so; so.init(S, D, F.G, (int)blockIdx.x);
        pg8::EpiMerged E{(bf16*)(F.ws + WS_MRG), R1 + 8192, R1 + 12288, NP, D}; pg8::gemm_phase<pg8::EpiMerged, pg8::StaticOrder, true, true, true>(ring, g, so, E); });
    PHASE(9, { pg8::Gemm g{(const bf16*)(F.ws + WS_MRG), (const bf16*)(F.ws + WS_WO), S, D, D}; pg8::StaticOrder so; so.init(S, D, F.G, (int)blockIdx.x);
        typedef pg8::EpiResidLN<WS_T, WS_HF, WS_STATS, WS_PART> EpiA; EpiA E{F.ws, (const float*)args.in[5], (const float*)args.in[6], 1.0f}; pg8::gemm_phase<EpiA, pg8::StaticOrder, true, true>(ring, g, so, E); });
    PHASE(10, { ln_phase<2>(F, HF, (const float*)args.in[16], (const float*)args.in[17], nullptr, HB, nullptr); });
    PHASE(11, { pg8::Gemm g{HB, (const bf16*)(F.ws + WS_WGU2), S, 2 * FF, D}; pg8::StaticOrder so; so.init(S, 2 * FF, F.G, (int)blockIdx.x);
        pg8::EpiSwiGLU E{R1, FF}; pg8::gemm_phase<pg8::EpiSwiGLU, pg8::StaticOrder, true, true>(ring, g, so, E);
        if (F.G == 256 && (int)blockIdx.x >= 192) p0_tiles(F, args, T_LATE, N_TILES, ((int)blockIdx.x - 192) * NWAVES + F.wave, 64 * NWAVES); });
    PHASE(12, { pg8::Gemm g{R1, (const bf16*)(F.ws + WS_WD2), S, D, FF}; pg8::StaticOrder so; so.init(S, D, F.G, (int)blockIdx.x);
        typedef pg8::EpiResidLN<WS_HF, WS_T, WS_STATS, WS_PART> EpiB; EpiB E{F.ws, (const float*)args.in[16], (const float*)args.in[17], 0.5f}; pg8::gemm_phase<EpiB, pg8::StaticOrder, true, true>(ring, g, so, E); });
    PHASE(13, { ln_phase<3>(F, T, (const float*)args.in[21], (const float*)args.in[22], args.out, nullptr, nullptr); });
#undef PHASE
#ifdef DBG_STOP
    if (lo == 100) {
        const size_t gt = (size_t)blockIdx.x * 512 + threadIdx.x, NT = (size_t)gridDim.x * 512;
        if (DBG_BF16) { const bf16* src = (const bf16*)(F.ws + (size_t)DBG_OFF_MIB * MiB); for (size_t i = gt; i < (size_t)S * D; i += NT) args.out[i] = i < (size_t)DBG_N ? bf2f(src[i]) : 0.f; }
        else { const float* src = (const float*)(F.ws + (size_t)DBG_OFF_MIB * MiB); for (size_t i = gt; i < (size_t)S * D; i += NT) args.out[i] = src[i]; }
    }
#endif
#undef IN
#undef SEAM
}

extern "C" void kernel_launch(void* const* d_in, const int* in_sizes, int n_in, void* d_out, int out_size, void* d_ws, size_t ws_size, hipStream_t stream) {
    static int grid = 0;
    if (grid == 0) {
        if (n_in != 23 || out_size != S * D || ws_size < WS_END2) { fprintf(stderr, "kernel_launch: unexpected problem (n_in %d out %d ws %zu need %zu)\n", n_in, out_size, ws_size, (size_t)WS_END2); grid = -1; return; }
        int dev = 0, cus = 0, per_cu = 0;
        if (hipGetDevice(&dev) != hipSuccess || hipDeviceGetAttribute(&cus, hipDeviceAttributeMultiprocessorCount, dev) != hipSuccess) { grid = -1; return; }
        if (hipFuncSetAttribute((const void*)fwd_kernel, hipFuncAttributeMaxDynamicSharedMemorySize, LDS_BYTES) != hipSuccess) { fprintf(stderr, "kernel_launch: hipFuncSetAttribute failed\n"); grid = -1; return; }
        if (hipOccupancyMaxActiveBlocksPerMultiprocessor(&per_cu, (const void*)fwd_kernel, NWAVES * 64, LDS_BYTES) != hipSuccess || per_cu < 1) { fprintf(stderr, "kernel_launch: occupancy query says %d\n", per_cu); }
        (void)hipGetLastError();
        grid = cus;
    }
    if (grid < 0) return;
    (void)hipMemsetAsync((char*)d_ws + WS_CTL, 0, CTL_ZERO_BYTES, stream);
#ifdef DBG_NANFILL
    (void)hipMemsetAsync((char*)d_ws + CTL_ZERO_BYTES, 0xFF, WS_END2 - CTL_ZERO_BYTES, stream);
#endif
    Args a{};
    for (int i = 0; i < 23; ++i) a.in[i] = d_in[i];
    a.out = (float*)d_out; a.ws = (unsigned char*)d_ws;
#if MK_ONE_LAUNCH
    a.ph_lo = 0; a.ph_hi = NPH;
    hipLaunchKernelGGL(fwd_kernel, dim3(grid), dim3(NWAVES * 64), LDS_BYTES, stream, a);
#else
#ifdef DBG_STOP
    for (int p = 0; p <= DBG_STOP; ++p) { a.ph_lo = p; a.ph_hi = p + 1; hipLaunchKernelGGL(fwd_kernel, dim3(grid), dim3(NWAVES * 64), LDS_BYTES, stream, a); }
    a.ph_lo = 100; a.ph_hi = 101; hipLaunchKernelGGL(fwd_kernel, dim3(grid), dim3(NWAVES * 64), LDS_BYTES, stream, a);
#else
    for (int p = 0; p < NPH; ++p) { a.ph_lo = p; a.ph_hi = p + 1; hipLaunchKernelGGL(fwd_kernel, dim3(grid), dim3(NWAVES * 64), LDS_BYTES, stream, a); }
#endif
#endif
}
```

```cpp
#include <hip/hip_runtime.h>
#include <cstdio>
#include <cstdint>
namespace pg8 {
#define PG8_LAS __attribute__((address_space(3)))
typedef unsigned short bf16_t;
typedef short bf16x8 __attribute__((ext_vector_type(8)));
typedef float f32x4 __attribute__((ext_vector_type(4)));
typedef unsigned u32x4 __attribute__((ext_vector_type(4)));
typedef int v4i32 __attribute__((ext_vector_type(4)));
typedef int v8i32 __attribute__((ext_vector_type(8)));
constexpr int BM = 256, BK = 64, HALF = 128, HTB = HALF * BK * 2  , STAGE_BYTES = 8 * HTB, NXCD = 8, WGM = 8;

__host__ __device__ __forceinline__ int lds_byte(int r, int c) { const int st = (r >> 4) * 2 + (c >> 5), rr = r & 15, cc = c & 31, ob = rr * 64 + cc * 2; return st * 1024 + (ob ^ (((ob >> 9) & 1) << 5)); }
__host__ __device__ __forceinline__ void stage_rc(int b, int& R, int& C) { const int st = b / 1024, sb = b % 1024, swz = sb ^ (((sb >> 9) & 1) << 5); R = (st >> 1) * 16 + swz / 64; C = (st & 1) * 32 + (swz % 64) / 2; }
__host__ __device__ __forceinline__ int perm32(int rho) { const int n = rho >> 4, i = rho & 15; return 8 * (i >> 2) + 4 * n + (i & 3); }

struct Unit { int pm, pn; };
struct Gemm { const bf16_t* A; const bf16_t* Bt; int M, N, K; };

struct StaticOrder {
    int nM, nN, nwg, G, c;
    __host__ __device__ void init(int M, int N, int G_, int c_) { nM = M / BM; nN = N / BM; nwg = nM * nN; G = G_; c = c_; }
    __host__ __device__ bool next(int i, Unit& u) const {
        const long L = (long)i * G + c; if (L >= nwg) return false;
        int wgid = (int)L; { const int q = nwg / NXCD, r = nwg % NXCD, xcd = wgid % NXCD, off = wgid / NXCD; wgid = (xcd < r ? xcd * (q + 1) : r * (q + 1) + (xcd - r) * q) + off; }
        const int nig = WGM * nN, gid = wgid / nig, fm = gid * WGM, gsz = (nM - fm) < WGM ? (nM - fm) : WGM;
        u.pm = fm + ((wgid % nig) % gsz); u.pn = (wgid % nig) / gsz; return true;
    }
    __device__ __forceinline__ void a_ready(const Unit&) const {}
    __device__ __forceinline__ void done(const Unit&) const {}
};
typedef float f32x2c __attribute__((ext_vector_type(2)));
typedef __bf16 bf16x2c __attribute__((ext_vector_type(2)));
__device__ __forceinline__ unsigned cvt_pk_bf16(float lo, float hi) { const f32x2c v = {lo, hi}; const bf16x2c r = __builtin_convertvector(v, bf16x2c); return __builtin_bit_cast(unsigned, r); }
typedef float f32x2 __attribute__((ext_vector_type(2)));
__device__ __forceinline__ float fast_sigmoid(float x) { return __builtin_amdgcn_rcpf(1.0f + __builtin_amdgcn_exp2f(-1.4426950408889634f * x)); }
__device__ __forceinline__ float bf_lo(unsigned w) { return __uint_as_float(w << 16); }
__device__ __forceinline__ float bf_hi(unsigned w) { return __uint_as_float(w & 0xffff0000u); }

struct EpiPlainBf16 {
    static constexpr bool PERM = true, AFTER_DRAIN = false;
    bf16_t* O; int ldc;
    __device__ __forceinline__ void operator()(const f32x4 (&acc)[2][2][4][2], const Unit& u, int wr, int wc, int fr, int fq) const {
        const int row0 = u.pm * BM + wr * 64 + fr; const int col0 = u.pn * BM + wc * 32 + 8 * fq;
#pragma unroll
        for (int ai = 0; ai < 2; ++ai)
#pragma unroll
            for (int m = 0; m < 4; ++m) { bf16_t* rowp = O + (size_t)(row0 + ai * HALF + m * 16) * ldc + col0;
#pragma unroll
                for (int bj = 0; bj < 2; ++bj) { const f32x4 v0 = acc[ai][bj][m][0], v1 = acc[ai][bj][m][1];
                    u32x4 w; w.x = cvt_pk_bf16(v0[0], v0[1]); w.y = cvt_pk_bf16(v0[2], v0[3]); w.z = cvt_pk_bf16(v1[0], v1[1]); w.w = cvt_pk_bf16(v1[2], v1[3]);
                    *(u32x4*)(rowp + bj * HALF) = w; } }
    }
};
struct EpiSwiGLU {
    static constexpr bool PERM = true, AFTER_DRAIN = false;
    bf16_t* H; int ldh;
    __device__ __forceinline__ void operator()(const f32x4 (&acc)[2][2][4][2], const Unit& u, int wr, int wc, int fr, int fq) const {
        const int row0 = u.pm * BM + wr * 64 + fr; const int col0 = u.pn * HALF + wc * 32 + 8 * fq;
#pragma unroll
        for (int ai = 0; ai < 2; ++ai)
#pragma unroll
            for (int m = 0; m < 4; ++m) { bf16_t* rowp = H + (size_t)(row0 + ai * HALF + m * 16) * ldh + col0;
                float o[8];
#pragma unroll
                for (int n = 0; n < 2; ++n)
#pragma unroll
                    for (int j = 0; j < 4; ++j) { const float g = acc[ai][0][m][n][j], up = acc[ai][1][m][n][j]; o[4 * n + j] = g * fast_sigmoid(g) * up; }
                u32x4 w; w.x = cvt_pk_bf16(o[0], o[1]); w.y = cvt_pk_bf16(o[2], o[3]); w.z = cvt_pk_bf16(o[4], o[5]); w.w = cvt_pk_bf16(o[6], o[7]);
                *(u32x4*)rowp = w; }
    }
};
struct EpiResid {
    static constexpr bool PERM = false, AFTER_DRAIN = false;
    const float* base; float* T; int ldc; float alpha, s; float* part;
    __device__ __forceinline__ void operator()(const f32x4 (&acc)[2][2][4][2], const Unit& u, int wr, int wc, int fr, int fq) const {
        const int row0 = u.pm * BM + wr * 64 + fr, col0 = u.pn * BM + wc * 32 + 4 * fq;
#pragma unroll
        for (int ai = 0; ai < 2; ++ai)
#pragma unroll
            for (int m = 0; m < 4; ++m) { const int row = row0 + ai * HALF + m * 16; const size_t off = (size_t)row * ldc + col0; float ps = 0.f, pq = 0.f;
#pragma unroll
                for (int bj = 0; bj < 2; ++bj)
#pragma unroll
                    for (int n = 0; n < 2; ++n) { const f32x4 b = *(const f32x4*)(base + off + bj * HALF + n * 16); const f32x4 o = b * alpha + acc[ai][bj][m][n] * s; *(f32x4*)(T + off + bj * HALF + n * 16) = o;
                        ps += (o[0] + o[1]) + (o[2] + o[3]); pq += (o[0] * o[0] + o[1] * o[1]) + (o[2] * o[2] + o[3] * o[3]); }
                ps += __shfl_xor(ps, 16); ps += __shfl_xor(ps, 32); pq += __shfl_xor(pq, 16); pq += __shfl_xor(pq, 32);
                if (fq == 0) { f32x2 pv; pv.x = ps; pv.y = pq; *(f32x2*)(part + ((size_t)row * 64 + u.pn * 4 + wc) * 2) = pv; } }
    }
};
template <size_t TIN_OFF, size_t TOUT_OFF, size_t STATS_OFF, size_t PART_OFF> struct EpiResidLN {
    static constexpr bool PERM = false, AFTER_DRAIN = false;
    unsigned char* ws; const float* lw; const float* lb; float s;
    __device__ __forceinline__ void operator()(const f32x4 (&acc)[2][2][4][2], const Unit& u, int, int, int, int) const {
        int tz = threadIdx.x; asm volatile("" : "+v"(tz));
        const int wid = tz >> 6, wr = wid >> 2, wc = wid & 3, fr = tz & 15, fq = (tz & 63) >> 4;
        const int row0 = u.pm * BM + wr * 64 + fr, col0 = u.pn * BM + wc * 32 + 4 * fq;
        constexpr int ldc = 4096; constexpr float alpha = 1.1892071150027210667f;
        const float* Tin = (const float*)(ws + TIN_OFF); float* Tout = (float*)(ws + TOUT_OFF); const float* stats = (const float*)(ws + STATS_OFF); float* part = (float*)(ws + PART_OFF);
        f32x4 wv[2][2], bv[2][2];
#pragma unroll
        for (int bj = 0; bj < 2; ++bj)
#pragma unroll
            for (int n = 0; n < 2; ++n) { wv[bj][n] = *(const f32x4*)(lw + col0 + bj * HALF + n * 16) * alpha; bv[bj][n] = *(const f32x4*)(lb + col0 + bj * HALF + n * 16) * alpha; }
#pragma unroll
        for (int ai = 0; ai < 2; ++ai)
#pragma unroll
            for (int m = 0; m < 4; ++m) { const int row = row0 + ai * HALF + m * 16; const size_t off = (size_t)row * ldc + col0;
                const float mean = stats[2 * row], rstd = stats[2 * row + 1]; float ps = 0.f, pq = 0.f;
#pragma unroll
                for (int bj = 0; bj < 2; ++bj)
#pragma unroll
                    for (int n = 0; n < 2; ++n) { const f32x4 t = *(const f32x4*)(Tin + off + bj * HALF + n * 16);
                        const f32x4 o = ((t - mean) * rstd) * wv[bj][n] + bv[bj][n] + acc[ai][bj][m][n] * s; *(f32x4*)(Tout + off + bj * HALF + n * 16) = o;
                        ps += (o[0] + o[1]) + (o[2] + o[3]); pq += (o[0] * o[0] + o[1] * o[1]) + (o[2] * o[2] + o[3] * o[3]); }
                ps += __shfl_xor(ps, 16); ps += __shfl_xor(ps, 32); pq += __shfl_xor(pq, 16); pq += __shfl_xor(pq, 32);
                if (fq == 0) { f32x2 pv; pv.x = ps; pv.y = pq; *(f32x2*)(part + ((size_t)row * 64 + u.pn * 4 + wc) * 2) = pv; } }
    }
};
struct EpiMerged {
    static constexpr bool PERM = true, AFTER_DRAIN = false;
    bf16_t* O; const bf16_t* ga; const bf16_t* gb; int ldg, ldc;
    __device__ __forceinline__ void mid(f32x4 (&acc)[2][2][4][2], const Unit& u, int, int, int, int) const {
        int tz = threadIdx.x; asm volatile("" : "+v"(tz));
        const int wid = tz >> 6, wr = wid >> 2, wc = wid & 3, fr = tz & 15, fq = (tz & 63) >> 4;
        const int row0 = u.pm * BM + wr * 64 + fr; const int col0 = u.pn * BM + wc * 32 + 8 * fq;
#pragma unroll
        for (int ai = 0; ai < 2; ++ai)
#pragma unroll
            for (int m = 0; m < 4; ++m) { const int row = row0 + ai * HALF + m * 16;
#pragma unroll
                for (int bj = 0; bj < 2; ++bj) { const size_t off = (size_t)row * ldg + col0 + bj * HALF;
                    const u32x4 a = *(const u32x4*)(ga + off), b = *(const u32x4*)(gb + off);
                    const unsigned aw[4] = {a.x, a.y, a.z, a.w}, bw[4] = {b.x, b.y, b.z, b.w};
#pragma unroll
                    for (int h = 0; h < 4; ++h) {
                        const float ea0 = __builtin_amdgcn_exp2f(-1.4426950408889634f * bf_lo(aw[h])), ea1 = __builtin_amdgcn_exp2f(-1.4426950408889634f * bf_hi(aw[h]));
                        const float eb0 = __builtin_amdgcn_exp2f(-1.4426950408889634f * bf_lo(bw[h])), eb1 = __builtin_amdgcn_exp2f(-1.4426950408889634f * bf_hi(bw[h]));
                        acc[ai][bj][m][h >> 1][2 * (h & 1)] *= (1.0f + eb0) * __builtin_amdgcn_rcpf(1.0f + ea0);
                        acc[ai][bj][m][h >> 1][2 * (h & 1) + 1] *= (1.0f + eb1) * __builtin_amdgcn_rcpf(1.0f + ea1); }
                }
                asm volatile("" ::: "memory"); }
    }
    __device__ __forceinline__ void operator()(const f32x4 (&acc)[2][2][4][2], const Unit& u, int, int, int, int) const {
        int tz = threadIdx.x; asm volatile("" : "+v"(tz));
        const int wid = tz >> 6, wr = wid >> 2, wc = wid & 3, fr = tz & 15, fq = (tz & 63) >> 4;
        const int row0 = u.pm * BM + wr * 64 + fr; const int col0 = u.pn * BM + wc * 32 + 8 * fq;
#pragma unroll
        for (int ai = 0; ai < 2; ++ai)
#pragma unroll
            for (int m = 0; m < 4; ++m) { const int row = row0 + ai * HALF + m * 16;
#pragma unroll
                for (int bj = 0; bj < 2; ++bj) { const int col = col0 + bj * HALF;
                    const u32x4 g = *(const u32x4*)(gb + (size_t)row * ldg + col);
                    const f32x4 v0 = acc[ai][bj][m][0], v1 = acc[ai][bj][m][1];
                    u32x4 w;
                    w.x = cvt_pk_bf16(fast_sigmoid(bf_lo(g.x)) * v0[0], fast_sigmoid(bf_hi(g.x)) * v0[1]); w.y = cvt_pk_bf16(fast_sigmoid(bf_lo(g.y)) * v0[2], fast_sigmoid(bf_hi(g.y)) * v0[3]);
                    w.z = cvt_pk_bf16(fast_sigmoid(bf_lo(g.z)) * v1[0], fast_sigmoid(bf_hi(g.z)) * v1[1]); w.w = cvt_pk_bf16(fast_sigmoid(bf_lo(g.w)) * v1[2], fast_sigmoid(bf_hi(g.w)) * v1[3]);
                    *(u32x4*)(O + (size_t)row * ldc + col) = w; } }
    }
};

template <class Epi, class Sched, bool ALIGN_EPI = false, bool SP2 = false, bool MID = false, bool FP8 = false>
__device__ __forceinline__ void gemm_phase(PG8_LAS unsigned char* lds, const Gemm g, const Sched& S, const Epi& E) {
    const int tid = threadIdx.x, wid = __builtin_amdgcn_readfirstlane(tid >> 6), lane = tid & 63, wr = wid >> 2, wc = wid & 3, fr = lane & 15, fq = lane >> 4;
    const int K = g.K, nt = K / BK;
    unsigned voffA[2], voffB[2];
#pragma unroll
    for (int i = 0; i < 2; ++i) { int R, C; stage_rc(tid * 16 + i * 8192, R, C); const int Rb = Epi::PERM ? ((R & ~31) + perm32(R & 31)) : R;
        voffA[i] = (unsigned)(R * K + C) * 2u; voffB[i] = (unsigned)(Rb * K + C) * 2u; }
    const size_t kstep = (size_t)(BK * 2);
    const size_t hstep = (size_t)HALF * K * 2;
    const size_t tstep = 2 * hstep;
    const unsigned ldsw = (unsigned)wid * 1024u;
    const int aoff = lds_byte(wr * 64 + fr, fq * 8), boff = lds_byte(wc * 32 + fr, fq * 8);
#define PG8_SA(b, h) (((b) * 2 + (h)) * HTB)
#define PG8_SB(b, h) ((4 + (b) * 2 + (h)) * HTB)
#define PG8_STAGE(bufoff, gbase, voff) do { _Pragma("unroll") for (int _i = 0; _i < 2; ++_i) \
        __builtin_amdgcn_global_load_lds((const unsigned*)((const char*)(gbase) + (voff)[_i]), (PG8_LAS unsigned*)(lds + (bufoff) + ldsw + _i * 8192), 16, 0, 0); } while (0)
#define PG8_LDA(dst, b, h) do { if constexpr (FP8) { _Pragma("unroll") for (int m = 0; m < 4; ++m) dst##8[m] = __builtin_shufflevector(*(const PG8_LAS v4i32*)(lds + PG8_SA(b, h) + aoff + m * 2048), *(const PG8_LAS v4i32*)(lds + PG8_SA(b, h) + aoff + m * 2048 + 1024), 0, 1, 2, 3, 4, 5, 6, 7); } \
    else { _Pragma("unroll") for (int m = 0; m < 4; ++m) _Pragma("unroll") for (int k = 0; k < 2; ++k) dst[m][k] = *(const PG8_LAS bf16x8*)(lds + PG8_SA(b, h) + aoff + m * 2048 + k * 1024); } } while (0)
#define PG8_LDB(dst, b, h) do { if constexpr (FP8) { _Pragma("unroll") for (int n = 0; n < 2; ++n) dst##8[n] = __builtin_shufflevector(*(const PG8_LAS v4i32*)(lds + PG8_SB(b, h) + boff + n * 2048), *(const PG8_LAS v4i32*)(lds + PG8_SB(b, h) + boff + n * 2048 + 1024), 0, 1, 2, 3, 4, 5, 6, 7); } \
    else { _Pragma("unroll") for (int n = 0; n < 2; ++n) _Pragma("unroll") for (int k = 0; k < 2; ++k) dst[n][k] = *(const PG8_LAS bf16x8*)(lds + PG8_SB(b, h) + boff + n * 2048 + k * 1024); } } while (0)
#define PG8_MMA(ai, bj, At, Bt) do { __builtin_amdgcn_s_setprio(1); _Pragma("unroll") for (int m = 0; m < 4; ++m) _Pragma("unroll") for (int n = 0; n < 2; ++n) { \
        if constexpr (FP8) { asm volatile("v_mfma_scale_f32_16x16x128_f8f6f4 %0, %1, %2, %0, %3, %4 op_sel_hi:[0,0,0]" : "+v"(acc[ai][bj][m][n]) : "v"(Bt##8[n]), "v"(At##8[m]), "v"(scl_w), "v"(scl_a)); } \
        else { _Pragma("unroll") for (int k = 0; k < 2; ++k) acc[ai][bj][m][n] = __builtin_amdgcn_mfma_f32_16x16x32_bf16(Bt[n][k], At[m][k], acc[ai][bj][m][n], 0, 0, 0); } } \
        __builtin_amdgcn_s_setprio(0); } while (0)
#define PG8_WAIT_V(n) asm volatile("s_waitcnt vmcnt(" #n ")" ::: "memory")
#define PG8_WAIT_L(n) asm volatile("s_waitcnt lgkmcnt(" #n ")" ::: "memory")
#define PG8_BAR __builtin_amdgcn_s_barrier()
#define PG8_SCHED __builtin_amdgcn_sched_barrier(0)
    Unit cur, nxt; int ui = 0;
    if (!S.next(0, cur)) return;
    f32x4 acc[2][2][4][2];
#pragma unroll
    for (int a = 0; a < 2; ++a)
#pragma unroll
        for (int b = 0; b < 2; ++b)
#pragma unroll
            for (int m = 0; m < 4; ++m)
#pragma unroll
                for (int n = 0; n < 2; ++n) acc[a][b][m][n] = (f32x4){0.f, 0.f, 0.f, 0.f};
    bf16x8 At[4][2], B0[2][2], B1[2][2];
    const int scl_w = 0x79797979, scl_a = 0x7F7F7F7F;
    v8i32 At8[4], B08[2], B18[2];
    const char* cA = (const char*)g.A + (size_t)cur.pm * tstep; const char* cB = (const char*)g.Bt + (size_t)cur.pn * tstep;
    S.a_ready(cur);
    if constexpr (SP2) {
        PG8_STAGE(PG8_SB(0, 0), cB, voffB); PG8_STAGE(PG8_SB(0, 1), cB + hstep, voffB); PG8_STAGE(PG8_SA(0, 0), cA, voffA); PG8_STAGE(PG8_SA(0, 1), cA + hstep, voffA);
        if (wr == 1) PG8_BAR;
        PG8_WAIT_V(2); PG8_BAR;
        PG8_STAGE(PG8_SB(1, 0), cB + kstep, voffB); PG8_STAGE(PG8_SA(1, 0), cA + kstep, voffA); PG8_STAGE(PG8_SB(1, 1), cB + hstep + kstep, voffB);
        PG8_WAIT_V(6); PG8_BAR;
    } else {
        PG8_STAGE(PG8_SB(0, 0), cB, voffB); PG8_STAGE(PG8_SA(0, 0), cA, voffA); PG8_STAGE(PG8_SB(0, 1), cB + hstep, voffB); PG8_STAGE(PG8_SA(0, 1), cA + hstep, voffA);
        if (wr == 1) PG8_BAR;
        PG8_WAIT_V(4); PG8_BAR;
        PG8_STAGE(PG8_SB(1, 0), cB + kstep, voffB); PG8_STAGE(PG8_SA(1, 0), cA + kstep, voffA); PG8_STAGE(PG8_SB(1, 1), cB + hstep + kstep, voffB);
        PG8_WAIT_V(6); PG8_BAR;
    }
    for (;;) {
        const bool has_next = S.next(ui + 1, nxt);
        const char* nA = has_next ? (const char*)g.A + (size_t)nxt.pm * tstep : cA; const char* nB = has_next ? (const char*)g.Bt + (size_t)nxt.pn * tstep : cB;
        for (int hf = 0; hf < (MID ? 2 : 1); ++hf) {
        if constexpr (MID) { if (hf == 1) E.mid(acc, cur, wr, wc, fr, fq); }
        for (int t = MID ? hf * (nt >> 1) : 0; t < (MID ? (hf + 1) * (nt >> 1) : nt); t += 2) {
            const bool last = (t == nt - 2);
            const char* a1 = cA + (size_t)(t + 1) * kstep;
            const char* a2 = last ? nA : cA + (size_t)(t + 2) * kstep; const char* b2 = last ? nB : cB + (size_t)(t + 2) * kstep;
            const char* a3 = a2 + kstep; const char* b3 = b2 + kstep;
            if (last && has_next) S.a_ready(nxt);
            if constexpr (SP2) {
            PG8_LDB(B0, 0, 0); PG8_LDB(B1, 0, 1); PG8_SCHED; PG8_LDA(At, 0, 0); PG8_STAGE(PG8_SA(1, 1), a1 + hstep, voffA);
            PG8_WAIT_V(8); PG8_WAIT_L(0); PG8_BAR; PG8_MMA(0, 0, At, B0); PG8_MMA(0, 1, At, B1); PG8_BAR; PG8_SCHED;
            PG8_LDA(At, 0, 1); PG8_STAGE(PG8_SB(0, 0), b2, voffB); PG8_STAGE(PG8_SB(0, 1), b2 + hstep, voffB); PG8_STAGE(PG8_SA(0, 0), a2, voffA);
            PG8_WAIT_V(8); PG8_WAIT_L(0); PG8_BAR; PG8_MMA(1, 0, At, B0); PG8_MMA(1, 1, At, B1); PG8_BAR; PG8_SCHED;
            PG8_LDB(B0, 1, 0); PG8_LDB(B1, 1, 1); PG8_SCHED; PG8_LDA(At, 1, 0); PG8_STAGE(PG8_SA(0, 1), a2 + hstep, voffA);
            PG8_WAIT_V(8); PG8_WAIT_L(0); PG8_BAR; PG8_MMA(0, 0, At, B0); PG8_MMA(0, 1, At, B1); PG8_BAR; PG8_SCHED;
            PG8_LDA(At, 1, 1); PG8_STAGE(PG8_SB(1, 0), b3, voffB); PG8_STAGE(PG8_SB(1, 1), b3 + hstep, voffB); PG8_STAGE(PG8_SA(1, 0), a3, voffA);
            PG8_WAIT_V(8); PG8_WAIT_L(0); PG8_BAR; PG8_MMA(1, 0, At, B0); PG8_MMA(1, 1, At, B1); PG8_BAR; PG8_SCHED;
            } else {
            PG8_LDB(B0, 0, 0); PG8_SCHED; PG8_LDA(At, 0, 0); PG8_STAGE(PG8_SA(1, 1), a1 + hstep, voffA);
            PG8_WAIT_L(8); PG8_BAR; PG8_WAIT_L(0); PG8_MMA(0, 0, At, B0); PG8_BAR; PG8_SCHED;
            PG8_LDB(B1, 0, 1); PG8_STAGE(PG8_SB(0, 0), b2, voffB);
            PG8_BAR; PG8_WAIT_L(0); PG8_MMA(0, 1, At, B1); PG8_BAR;
            PG8_LDA(At, 0, 1); PG8_STAGE(PG8_SA(0, 0), a2, voffA);
            PG8_BAR; PG8_WAIT_L(0); PG8_MMA(1, 0, At, B0); PG8_BAR; PG8_SCHED;
            PG8_STAGE(PG8_SB(0, 1), b2 + hstep, voffB);
            PG8_WAIT_V(6); PG8_BAR; PG8_MMA(1, 1, At, B1); PG8_BAR;
            PG8_LDB(B0, 1, 0); PG8_SCHED; PG8_LDA(At, 1, 0); PG8_STAGE(PG8_SA(0, 1), a2 + hstep, voffA);
            PG8_WAIT_L(8); PG8_BAR; PG8_WAIT_L(0); PG8_MMA(0, 0, At, B0); PG8_BAR; PG8_SCHED;
            PG8_LDB(B1, 1, 1); PG8_STAGE(PG8_SB(1, 0), b3, voffB);
            PG8_BAR; PG8_WAIT_L(0); PG8_MMA(0, 1, At, B1); PG8_BAR;
            PG8_LDA(At, 1, 1); PG8_STAGE(PG8_SA(1, 0), a3, voffA);
            PG8_BAR; PG8_WAIT_L(0); PG8_MMA(1, 0, At, B0); PG8_BAR; PG8_SCHED;
            PG8_STAGE(PG8_SB(1, 1), b3 + hstep, voffB);
            PG8_WAIT_V(6); PG8_BAR; PG8_MMA(1, 1, At, B1); PG8_BAR;
            }
        }
        }
        if constexpr (FP8) asm volatile("s_nop 15\n\ts_nop 15\n\ts_nop 15" ::: "memory");
        if constexpr (ALIGN_EPI) { if (wr == 0) PG8_BAR; }
        if constexpr (!Epi::AFTER_DRAIN) { E(acc, cur, wr, wc, fr, fq); S.done(cur); }
        if (!has_next) break;
#pragma unroll
        for (int a = 0; a < 2; ++a)
#pragma unroll
            for (int b = 0; b < 2; ++b)
#pragma unroll
                for (int m = 0; m < 4; ++m)
#pragma unroll
                    for (int n = 0; n < 2; ++n) acc[a][b][m][n] = (f32x4){0.f, 0.f, 0.f, 0.f};
        cur = nxt; cA = nA; cB = nB; ++ui;
        if constexpr (ALIGN_EPI) { if (wr == 1) PG8_BAR; }
    }
    PG8_WAIT_V(0);
    if constexpr (!ALIGN_EPI) { if (wr == 0) PG8_BAR; }
    PG8_BAR;
    if constexpr (Epi::AFTER_DRAIN) { E.fused(acc, cur, wr, wc, fr, fq, lds, wid, lane); S.done(cur); }
#undef PG8_SA
#undef PG8_SB
#undef PG8_STAGE
#undef PG8_LDA
#undef PG8_LDB
#undef PG8_MMA
#undef PG8_WAIT_V
#undef PG8_WAIT_L
#undef PG8_BAR
#undef PG8_SCHED
}
}

constexpr int NWAVES = 8;
constexpr int S = 8192, D = 4096, FF = 11008, DIN = 20488, NP = 16384;
constexpr int NPH = 14;
#ifndef MK_ONE_LAUNCH
#define MK_ONE_LAUNCH 1
#endif
constexpr float ALPHA = 1.1892071150027210667f;
constexpr float LN_EPS = 1e-5f, HEAD_EPS = 1e-6f;

constexpr size_t MiB = 1u << 20, KiB = 1u << 10;
constexpr size_t WS_CTL = 0, CTL_ZERO_BYTES = 1 * MiB;
constexpr size_t WS_WIF = 1 * MiB;
constexpr size_t WS_GATES = WS_WIF + 128 * KiB;
constexpr size_t WS_AARR = WS_GATES + 256 * KiB;
constexpr size_t WS_MARR = WS_AARR + 128 * KiB;
constexpr size_t WS_BMARR = WS_MARR + 128 * KiB;
constexpr size_t WS_NPREV = WS_BMARR + 128 * KiB;
constexpr size_t WS_WGU1 = 4 * MiB;
constexpr size_t WS_WD1 = WS_WGU1 + 172 * MiB;
constexpr size_t WS_WIN = WS_WD1 + 86 * MiB;
constexpr size_t WS_WPM = WS_WIN + 160 * MiB;
constexpr size_t WS_WPR = WS_WPM + 16 * MiB;
constexpr size_t WS_WO = WS_WPR + 16 * MiB;
constexpr size_t WS_WGU2 = WS_WO + 32 * MiB;
constexpr size_t WS_WD2 = WS_WGU2 + 172 * MiB;
constexpr size_t WS_R1 = WS_WD2 + 86 * MiB;
constexpr size_t WS_T = WS_R1 + 256 * MiB;
constexpr size_t WS_HF = WS_T + 128 * MiB;
constexpr size_t WS_HB = WS_HF + 128 * MiB;
constexpr size_t WS_XB = WS_HB + 64 * MiB;
constexpr size_t WS_END = WS_XB + 64 * MiB;
constexpr size_t WS_VT = WS_WGU1;
constexpr size_t WS_U = WS_END;
constexpr size_t WS_END2 = WS_U + 128 * MiB;
constexpr size_t WS_QA = WS_WGU1 + 64 * MiB;
constexpr size_t WS_STATS = 2 * MiB;
constexpr size_t WS_PART = WS_WGU1 + 128 * MiB;
constexpr size_t WS_KTW = WS_T + 64 * MiB;
constexpr size_t WS_Y = WS_HB;
constexpr size_t WS_MRG = WS_XB;
constexpr size_t WS_H8 = WS_XB;
constexpr size_t WS_W8 = WS_WIN + (size_t)6144 * 4096 * 2;
constexpr int CW_BAR = 4096;

constexpr int LDS_BYTES = 147456;
constexpr int MISC_OFF = LDS_BYTES - 512;

#define GAS __attribute__((address_space(1)))
#define LAS __attribute__((address_space(3)))
typedef unsigned short bf16;
typedef unsigned v4u __attribute__((ext_vector_type(4)));
typedef unsigned v2u __attribute__((ext_vector_type(2)));
typedef float f32x4 __attribute__((ext_vector_type(4)));
typedef short bf16x8 __attribute__((ext_vector_type(8)));
typedef float f32x2q __attribute__((ext_vector_type(2)));
#define LDS_WAIT() asm volatile("s_waitcnt lgkmcnt(0)" ::: "memory")
#define VM_WAIT() asm volatile("s_waitcnt vmcnt(0)" ::: "memory")
using pg8::cvt_pk_bf16; using pg8::bf_lo; using pg8::bf_hi; using pg8::fast_sigmoid;

#define XB_TMO      128
#define XB_XCNT(j)  (256  + 64 * (j))
#define XB_XSUB(j)  (1280 + 64 * (j))
#define XB_XGEN(j)  (2304 + 64 * (j))
#define XB_TOP      3328
#define XB_TOPGEN   3392
#define XCD_BAR_WORDS 3456
#define XB_SPIN_CAP (1u << 22)

__device__ __forceinline__ unsigned xb_ld(unsigned* p)              { return __hip_atomic_load(p, __ATOMIC_RELAXED, __HIP_MEMORY_SCOPE_AGENT); }
__device__ __forceinline__ unsigned xb_add(unsigned* p, unsigned v) { return __hip_atomic_fetch_add(p, v, __ATOMIC_RELAXED, __HIP_MEMORY_SCOPE_AGENT); }
__device__ __forceinline__ unsigned xb_xcc_id() { return (unsigned)__builtin_amdgcn_s_getreg((3 << 11) | 20) & 0xFu; }
#define XB_SPIN(cond, bar) do { unsigned _sp = 0; while (cond) { __builtin_amdgcn_s_sleep(1); \
    if ((++_sp & 255u) == 0u) { if (xb_ld(&(bar)[XB_TMO])) break; if (_sp > XB_SPIN_CAP) { atomicAdd(&(bar)[XB_TMO], 1u); break; } } } } while (0)

struct XcdBarrier {
    unsigned* bar; unsigned x;
    volatile LAS unsigned* st;
};

__device__ __forceinline__ XcdBarrier xcd_barrier_post(unsigned* bar, volatile LAS unsigned* st) {
    XcdBarrier b; b.bar = bar; b.x = xb_xcc_id(); b.st = st;
    if (threadIdx.x == 0) (void)xb_add(&bar[XB_XCNT(b.x)], 1u);
    return b;
}
__device__ __forceinline__ void xcd_barrier_complete(unsigned* bar, unsigned x, unsigned& nloc, unsigned& nx) {
    const unsigned G = gridDim.x * gridDim.y * gridDim.z;
    unsigned sum, cnt, mine, sp = 0u;
    for (;;) {
        sum = 0u; cnt = 0u; mine = 0u;
#pragma unroll
        for (unsigned j = 0; j < 16; ++j) { const unsigned c = xb_ld(&bar[XB_XCNT(j)]); sum += c; cnt += (c > 0u) ? 1u : 0u; mine = (j == x) ? c : mine; }
        if (sum == G) break;
        __builtin_amdgcn_s_sleep(1);
        if ((++sp & 255u) == 0u) { if (xb_ld(&bar[XB_TMO])) break; if (sp > XB_SPIN_CAP) { atomicAdd(&bar[XB_TMO], 1u); break; } }
    }
    nloc = mine > 0u ? mine : 1u; nx = cnt > 0u ? cnt : 1u;
}

__device__ __forceinline__ void xcd_barrier(const XcdBarrier& b) {
    asm volatile("s_waitcnt vmcnt(0)" ::: "memory");
    __syncthreads();
    if (threadIdx.x == 0) {
        unsigned* bar = b.bar;
        __builtin_amdgcn_s_waitcnt(0);
        unsigned nloc = b.st[0], nx = b.st[1];
        if (nloc == 0u) { xcd_barrier_complete(bar, b.x, nloc, nx); b.st[0] = nloc; b.st[1] = nx; }
        const unsigned old = xb_add(&bar[XB_XSUB(b.x)], 1u);
        const unsigned gen = old / nloc;
        if (old + 1u == (gen + 1u) * nloc) {
            __builtin_amdgcn_fence(__ATOMIC_RELEASE, "agent");
            asm volatile("s_waitcnt vmcnt(0)" ::: "memory");
            const unsigned og = xb_add(&bar[XB_TOP], 1u);
            const unsigned tg = og / nx;
            if (og + 1u == (tg + 1u) * nx) xb_add(&bar[XB_TOPGEN], 1u);
            else XB_SPIN(xb_ld(&bar[XB_TOPGEN]) == tg, bar);
            __builtin_amdgcn_fence(__ATOMIC_ACQUIRE, "agent");
            xb_add(&bar[XB_XGEN(b.x)], 1u);
            asm volatile("s_waitcnt vmcnt(0)" ::: "memory");
        } else {
            XB_SPIN(xb_ld(&bar[XB_XGEN(b.x)]) == gen, bar);
            __builtin_amdgcn_fence(__ATOMIC_ACQUIRE, "agent");
            asm volatile("s_waitcnt vmcnt(0)" ::: "memory");
        }
    }
    __syncthreads();
}

__device__ __forceinline__ float wave_sum(float v) {
#pragma unroll
    for (int o = 1; o < 64; o <<= 1) v += __shfl_xor(v, o);
    return v;
}
__device__ __forceinline__ float bf2f(unsigned short b) { return __uint_as_float(((unsigned)b) << 16); }
__device__ __forceinline__ float fast_silu(float x) { return x * fast_sigmoid(x); }

struct Frame {
    LAS unsigned char* lds;
    unsigned char* ws;
    const void* const* in;
    int tid, lane, wave, vcu, G;
};

struct Seg { int in_idx, ldw, col0, ntn, ldt, row0, map, dst_mib, tile_end, koff; };
__constant__ Seg c_segs[16] = {
    { 2, FF, 0, 172, D, 0, 1, (int)(WS_WGU1 / MiB), 11008, 0},
    { 3, FF, 0, 172, D, 0, 2, (int)(WS_WGU1 / MiB), 22016, 0},
    { 4, D, 0, 64, FF, 0, 0, (int)(WS_WD1 / MiB), 33024, 0},
    { 7, DIN, 0, 32, D, 0, 0, (int)(WS_WIN / MiB), 35072, 0},
    { 7, DIN, 4096, 32, D, 0, 3, (int)(WS_WIN / MiB), 37120, 0},
    { 7, DIN, 6152, 32, D, 2048, 0, (int)(WS_WIN / MiB), 39168, 0},
    { 7, DIN, 10248, 32, D, 4096, 0, (int)(WS_WIN / MiB), 41216, 0},
    { 7, DIN, 12296, 128, D, 2048, 3, (int)(WS_WIN / MiB), 49408, 0},
    { 7, DIN, 2048, 32, D, 16384, 0, (int)(WS_WIN / MiB), 51456, 0},
    { 7, DIN, 8200, 32, D, 18432, 0, (int)(WS_WIN / MiB), 53504, 0},
    {13, D, 0, 64, D, 0, 0, (int)(WS_WPM / MiB), 55552, 0},
    {14, D, 0, 64, D, 0, 0, (int)(WS_WPM / MiB), 57600, 2048},
    {15, D, 0, 64, D, 0, 0, (int)(WS_WO / MiB), 61696, 0},
    {18, FF, 0, 172, D, 0, 1, (int)(WS_WGU2 / MiB), 72704, 0},
    {19, FF, 0, 172, D, 0, 2, (int)(WS_WGU2 / MiB), 83712, 0},
    {20, D, 0, 64, FF, 0, 0, (int)(WS_WD2 / MiB), 94720, 0},
};
constexpr int N_TILES = 94720;

struct Args { const void* in[23]; float* out; unsigned char* ws; int ph_lo, ph_hi; };

struct TileDesc { const float* p; bf16* d; int ldw, ldt, fp8; };
__device__ __forceinline__ TileDesc p0_decode(const Args& a, unsigned char* ws, int it, int lane) {
    int si = 0;
#pragma unroll
    for (int q = 0; q < 15; ++q) si += (it >= c_segs[q].tile_end) ? 1 : 0;
    const Seg sg = c_segs[si];
    const int t = it - (si ? c_segs[si - 1].tile_end : 0);
    const int kg = 4;
    const int g4 = t / (kg * sg.ntn), rem = t - g4 * kg * sg.ntn, nb = rem / kg, kb = kg * g4 + (rem - nb * kg);
    const int n0 = 64 * nb;
    int r0 = sg.row0 + n0;
    if (sg.map == 1 || sg.map == 2) r0 = (n0 >> 7) * 256 + (n0 & 127) + (sg.map == 2 ? 128 : 0);
    TileDesc td;
    td.ldw = sg.ldw; td.ldt = sg.ldt; td.fp8 = sg.map == 3;
    if (sg.map == 3) {
        td.p = (const float*)a.in[sg.in_idx] + (size_t)(64 * kb + 4 * (lane >> 4)) * sg.ldw + sg.col0 + n0 + 4 * (lane & 15);
        td.d = (bf16*)(ws + WS_W8 + (size_t)(sg.row0 + n0 + (lane >> 2)) * 4096 + 64 * kb + 16 * (lane & 3));
        return td;
    }
    td.p = (const float*)a.in[sg.in_idx] + (size_t)(64 * kb + 2 * (lane >> 4)) * sg.ldw + sg.col0 + n0 + 4 * (lane & 15);
    td.d = (bf16*)(ws + (size_t)sg.dst_mib * MiB) + (size_t)(r0 + (lane >> 3)) * sg.ldt + sg.koff + 64 * kb + 8 * (lane & 7);
    return td;
}
__device__ __forceinline__ void p0_load(const TileDesc& td, f32x4 (&v)[16]) {
    if (td.fp8) {
#pragma unroll
        for (int i = 0; i < 4; ++i)
#pragma unroll
            for (int e = 0; e < 4; ++e) v[4 * i + e] = __builtin_nontemporal_load((const f32x4*)(td.p + (size_t)(16 * i + e) * td.ldw));
        return;
    }
#pragma unroll
    for (int i = 0; i < 8; ++i) { v[2 * i] = __builtin_nontemporal_load((const f32x4*)(td.p + (size_t)(8 * i) * td.ldw)); v[2 * i + 1] = __builtin_nontemporal_load((const f32x4*)(td.p + (size_t)(8 * i + 1) * td.ldw)); }
}
__device__ __forceinline__ unsigned pack4_fp8(float a, float b, float c, float d) { int w = 0; w = __builtin_amdgcn_cvt_pk_fp8_f32(a, b, w, false); w = __builtin_amdgcn_cvt_pk_fp8_f32(c, d, w, true); return (unsigned)w; }
__device__ __forceinline__ void p0_store(const TileDesc& td, const f32x4 (&v)[16], LAS unsigned* scr, int lane) {
    const int q = lane & 15, r = lane >> 4;
    if (td.fp8) {
#pragma unroll
        for (int i = 0; i < 4; ++i) { LAS unsigned* s = scr + (4 * q) * 16 + 4 * (i ^ (q & 3)) + r;
            s[0] = pack4_fp8(v[4 * i].x * 64.f, v[4 * i + 1].x * 64.f, v[4 * i + 2].x * 64.f, v[4 * i + 3].x * 64.f);
            s[16] = pack4_fp8(v[4 * i].y * 64.f, v[4 * i + 1].y * 64.f, v[4 * i + 2].y * 64.f, v[4 * i + 3].y * 64.f);
            s[32] = pack4_fp8(v[4 * i].z * 64.f, v[4 * i + 1].z * 64.f, v[4 * i + 2].z * 64.f, v[4 * i + 3].z * 64.f);
            s[48] = pack4_fp8(v[4 * i].w * 64.f, v[4 * i + 1].w * 64.f, v[4 * i + 2].w * 64.f, v[4 * i + 3].w * 64.f); }
        LDS_WAIT();
        const int g = lane & 3;
#pragma unroll
        for (int j = 0; j < 4; ++j) { const int n = (lane >> 2) + 16 * j;
            const v4u o = *(const LAS v4u*)(scr + n * 16 + 4 * (g ^ ((n >> 2) & 3)));
            __builtin_nontemporal_store(o, (v4u*)((unsigned char*)td.d + (size_t)(16 * j) * 4096)); }
        LDS_WAIT();
        return;
    }
#pragma unroll
    for (int i = 0; i < 8; ++i) { LAS unsigned* s = scr + (4 * q) * 32 + 4 * (i ^ (q & 7)) + r;
        s[0] = cvt_pk_bf16(v[2 * i].x, v[2 * i + 1].x); s[32] = cvt_pk_bf16(v[2 * i].y, v[2 * i + 1].y); s[64] = cvt_pk_bf16(v[2 * i].z, v[2 * i + 1].z); s[96] = cvt_pk_bf16(v[2 * i].w, v[2 * i + 1].w); }
    LDS_WAIT();
    const int g = lane & 7;
#pragma unroll
    for (int j = 0; j < 8; ++j) { const int n = (lane >> 3) + 8 * j;
        const v4u o = *(const LAS v4u*)(scr + n * 32 + 4 * (g ^ ((n >> 2) & 7)));
        __builtin_nontemporal_store(o, (v4u*)(td.d + (size_t)(8 * j) * td.ldt)); }
    LDS_WAIT();
}

__device__ __forceinline__ void p0_tiles(Frame& F, const Args& a, int t_lo, int t_hi, int gw, int ngw) {
    int tz_ = threadIdx.x; asm volatile("" : "+v"(tz_)); const int lane_ = tz_ & 63;
    LAS unsigned* scr = (LAS unsigned*)(F.lds + F.wave * 8192);
    f32x4 va[16], vb[16], vc[16];
    TileDesc da, db, dc;
    const int it0 = t_lo + gw;
    da = p0_decode(a, F.ws, it0 < t_hi ? it0 : t_lo, lane_); db = da; dc = da;
    if (it0 < t_hi) p0_load(da, va);
    if (it0 + ngw < t_hi) { db = p0_decode(a, F.ws, it0 + ngw, lane_); p0_load(db, vb); }
    for (int it = it0; it < t_hi; it += 3 * ngw) {
        if (it + 2 * ngw < t_hi) { dc = p0_decode(a, F.ws, it + 2 * ngw, lane_); p0_load(dc, vc); }
        p0_store(da, va, scr, lane_);
        if (it + 3 * ngw < t_hi) { da = p0_decode(a, F.ws, it + 3 * ngw, lane_); p0_load(da, va); }
        if (it + ngw < t_hi) p0_store(db, vb, scr, lane_);
        if (it + 4 * ngw < t_hi) { db = p0_decode(a, F.ws, it + 4 * ngw, lane_); p0_load(db, vb); }
        if (it + 2 * ngw < t_hi) p0_store(dc, vc, scr, lane_);
    }
}
constexpr int T_WD1_LO = 22016, T_WD1_HI = 33024;
constexpr int T_LATE = 83712;
__device__ __forceinline__ void p0_convert(Frame& F, const Args& a) {
    int tz_ = threadIdx.x; asm volatile("" : "+v"(tz_)); const int lane_ = tz_ & 63;
    p0_tiles(F, a, 0, T_WD1_LO, F.vcu * NWAVES + F.wave, F.G * NWAVES);
    p0_tiles(F, a, F.G == 256 ? T_WD1_HI : T_WD1_LO, F.G == 256 ? T_LATE : N_TILES, F.vcu * NWAVES + F.wave, F.G * NWAVES);
    const int gt = (F.vcu * NWAVES + F.wave) * 64 + lane_, NGT = F.G * NWAVES * 64;
    if (gt < 8 * D) { const int g = gt >> 12, k = gt & (D - 1); ((float*)(F.ws + WS_WIF))[gt] = ((const float*)a.in[7])[(size_t)k * DIN + 6144 + g]; }
    const float* x = (const float*)a.in[0]; bf16* xb = (bf16*)(F.ws + WS_XB);
    for (size_t i = (size_t)gt * 8; i < (size_t)S * D; i += (size_t)NGT * 8) {
        const f32x4 u0 = *(const f32x4*)(x + i), u1 = *(const f32x4*)(x + i + 4);
        v4u o; o.x = cvt_pk_bf16(u0.x, u0.y); o.y = cvt_pk_bf16(u0.z, u0.w); o.z = cvt_pk_bf16(u1.x, u1.y); o.w = cvt_pk_bf16(u1.z, u1.w);
        *(v4u*)(xb + i) = o;
    }
}

template <int MODE> __device__ __forceinline__ void ln_phase(Frame& F, const float* __restrict__ T, const float* __restrict__ w, const float* __restrict__ b,
                                                             float* __restrict__ OF, bf16* __restrict__ OB, const float* __restrict__ if_bias) {
    int tz_ = threadIdx.x; asm volatile("" : "+v"(tz_)); const int tid_ = tz_, lane_ = tz_ & 63;
    if (MODE == 1) {
        const v4u* srcw = (const v4u*)(F.ws + WS_WIF); LAS v4u* dl = (LAS v4u*)F.lds;
        for (int i = tid_; i < 8192; i += NWAVES * 64) dl[i] = srcw[i];
        LDS_WAIT(); __syncthreads();
    }
    const int gw = F.vcu * NWAVES + F.wave, NGW = F.G * NWAVES;
    const f32x4* w4 = (const f32x4*)w + lane_; const f32x4* b4 = (const f32x4*)b + lane_;
    const LAS f32x4* wl = (const LAS f32x4*)F.lds + lane_;
    for (int row = gw; row < S; row += NGW) {
        const f32x4* xr = (const f32x4*)(T + (size_t)row * D) + lane_;
        float s, ss;
        { const f32x2q pv = ((const f32x2q*)(F.ws + WS_PART))[(size_t)row * 64 + lane_]; s = wave_sum(pv.x); ss = wave_sum(pv.y); }
        const float mean = s * (1.f / D);
        const float var = fmaxf(ss * (1.f / D) - mean * mean, 0.f);
        const float rstd = 1.f / sqrtf(var + LN_EPS);
        f32x4* of = (f32x4*)(OF + (size_t)row * D) + lane_;
        if (MODE != 3 && lane_ == 0) { float* st = (float*)(F.ws + WS_STATS) + 2 * row; st[0] = mean; st[1] = rstd; }
        v2u* ob = (v2u*)(OB + (size_t)row * D) + lane_;
        float g[8];
#pragma unroll
        for (int q = 0; q < 8; ++q) g[q] = 0.f;
        constexpr int LN_UNR = MODE == 1 ? 4 : 8;
#pragma unroll LN_UNR
        for (int j = 0; j < 16; ++j) {
            const f32x4 y = (xr[64 * j] - mean) * rstd * w4[64 * j] + b4[64 * j];
            if (MODE == 3) of[64 * j] = y;
            if (MODE != 3) { v2u o; o.x = cvt_pk_bf16(y.x, y.y); o.y = cvt_pk_bf16(y.z, y.w); ob[64 * j] = o; }
            if (MODE == 1) ((unsigned*)(F.ws + WS_H8 + (size_t)row * D))[lane_ + 64 * j] = pack4_fp8(y.x, y.y, y.z, y.w);
            if (MODE == 1) {
#pragma unroll
                for (int q = 0; q < 8; ++q) { const f32x4 ww = wl[q * 1024 + 64 * j]; g[q] += (y.x * ww.x + y.y * ww.y) + (y.z * ww.z + y.w * ww.w); }
            }
        }
        if (MODE == 1) {
#pragma unroll
            for (int q = 0; q < 8; ++q) g[q] = wave_sum(g[q]);
            if (lane_ == 0) { float* go = (float*)(F.ws + WS_GATES) + (size_t)row * 8;
#pragma unroll
                for (int q = 0; q < 8; ++q) go[q] = g[q] + if_bias[q]; }
        }
    }
}

__device__ __forceinline__ float log_sigmoid(float x) { return fminf(x, 0.f) - log1pf(expf(-fabsf(x))); }
__device__ __forceinline__ void gate_scan(Frame& F, int head) {
    int tz_ = threadIdx.x; asm volatile("" : "+v"(tz_)); const int tid_ = tz_, lane_ = tz_ & 63;
    const float* gates = (const float*)(F.ws + WS_GATES);
    float* aArr = (float*)(F.ws + WS_AARR) + head * S; float* MArr = (float*)(F.ws + WS_MARR) + head * S; float* BmArr = (float*)(F.ws + WS_BMARR) + head * S;
    LAS float* sc = (LAS float*)F.lds;
    const int t0 = tid_ * 16;
    float lf[16], iv[16];
    float run = 0.f;
    {
        LAS float* gl = sc + 64;
        const f32x4* g4 = (const f32x4*)gates;
#pragma unroll 8
        for (int k = 0; k < 32; ++k) { const int q = tid_ + 512 * k; const f32x4 v = g4[q]; gl[(q & 1) * S + (q >> 1)] = v[head]; }
        LDS_WAIT(); __syncthreads();
#pragma unroll
        for (int j = 0; j < 16; ++j) { iv[j] = gl[t0 + j]; run += log_sigmoid(gl[S + t0 + j]); lf[j] = run; }
    }
    float incl = run;
#pragma unroll
    for (int o = 1; o < 64; o <<= 1) { const float u = __shfl_up(incl, o); if (lane_ >= o) incl += u; }
    if (lane_ == 63) sc[F.wave] = incl;
    LDS_WAIT(); __syncthreads();
    float woff = 0.f;
    for (int w = 0; w < F.wave; ++w) woff += sc[w];
    const float excl = woff + incl - run;
    float mx = -INFINITY;
#pragma unroll
    for (int j = 0; j < 16; ++j) { const float B = excl + lf[j]; const float av = iv[j] - B; mx = fmaxf(mx, av); aArr[t0 + j] = av; lf[j] = B; iv[j] = mx; }
    float im = mx;
#pragma unroll
    for (int o = 1; o < 64; o <<= 1) { const float u = __shfl_up(im, o); if (lane_ >= o) im = fmaxf(im, u); }
    if (lane_ == 63) sc[16 + F.wave] = im;
    LDS_WAIT(); __syncthreads();
    float wm = -INFINITY;
    for (int w = 0; w < F.wave; ++w) wm = fmaxf(wm, sc[16 + w]);
    float prev = __shfl_up(im, 1); if (lane_ == 0) prev = -INFINITY;
    const float em = fmaxf(wm, prev);
#pragma unroll
    for (int j = 0; j < 16; ++j) { const float M = fmaxf(0.f, fmaxf(em, iv[j])); MArr[t0 + j] = M; BmArr[t0 + j] = lf[j] + M; }
    __syncthreads();
}

constexpr int P5_KP = 258;
__device__ __forceinline__ void p5_states(Frame& F, const Args& a) {
    int tz_ = threadIdx.x; asm volatile("" : "+v"(tz_)); const int tid_ = tz_;
    const bf16* proj = (const bf16*)(F.ws + WS_R1); bf16* QA = (bf16*)(F.ws + WS_QA); const bf16* VT = (const bf16*)(F.ws + WS_VT); bf16* U = (bf16*)(F.ws + WS_U);
    const float* convw = (const float*)a.in[9]; const float* convb = (const float*)a.in[10]; const int* positions = (const int*)a.in[1];
    LAS bf16* KW = (LAS bf16*)F.lds;
    float invf[16];
#pragma unroll
    for (int e = 0; e < 16; ++e) invf[e] = exp2f(-(float)((tid_ & 7) * 16 + e) * (13.287712379549449f / 128.0f));
    for (int unit = F.vcu; unit < 512; unit += F.G) {
        int tu = tid_; asm volatile("" : "+v"(tu));
        const int tl = tu >> 3, cb = tu & 7, fr = tu & 15, fq = (tu & 63) >> 4;
        const int mh = unit >> 6, c = unit & 63;
        if (mh < 4) {
            const int head = mh, tg = tu >> 5, cq = tu & 31, t0 = c * 128 + tg * 8;
            float wkv[8];
            { const float* aA = (const float*)(F.ws + WS_AARR) + head * S + t0; const float Mend = ((const float*)(F.ws + WS_MARR))[head * S + c * 128 + 127];
                const f32x4 a0 = *(const f32x4*)aA, a1 = *(const f32x4*)(aA + 4);
                wkv[0] = __expf(a0.x - Mend); wkv[1] = __expf(a0.y - Mend); wkv[2] = __expf(a0.z - Mend); wkv[3] = __expf(a0.w - Mend);
                wkv[4] = __expf(a1.x - Mend); wkv[5] = __expf(a1.y - Mend); wkv[6] = __expf(a1.z - Mend); wkv[7] = __expf(a1.w - Mend); }
#pragma unroll
            for (int part = 0; part < 2; ++part) {
                const int col = part * 1024 + head * 256 + cq * 8;
                float wt[4][8], bb[8];
#pragma unroll
                for (int j = 0; j < 4; ++j) { const f32x4 w0 = *(const f32x4*)(convw + j * 2048 + col), w1 = *(const f32x4*)(convw + j * 2048 + col + 4);
                    wt[j][0] = w0.x; wt[j][1] = w0.y; wt[j][2] = w0.z; wt[j][3] = w0.w; wt[j][4] = w1.x; wt[j][5] = w1.y; wt[j][6] = w1.z; wt[j][7] = w1.w; }
                { const f32x4 b0 = *(const f32x4*)(convb + col), b1 = *(const f32x4*)(convb + col + 4); bb[0] = b0.x; bb[1] = b0.y; bb[2] = b0.z; bb[3] = b0.w; bb[4] = b1.x; bb[5] = b1.y; bb[6] = b1.z; bb[7] = b1.w; }
                v4u xr[11];
#pragma unroll
                for (int r = 0; r < 11; ++r) { const int tt = t0 - 3 + r; xr[r] = tt >= 0 ? *(const v4u*)(proj + (size_t)tt * NP + col) : (v4u){0u, 0u, 0u, 0u}; }
                const float sc = part == 0 ? 0.0625f : 1.0f;
#pragma unroll
                for (int tk = 0; tk < 8; ++tk) {
                    float acc[8];
#pragma unroll
                    for (int e = 0; e < 8; ++e) acc[e] = bb[e];
#pragma unroll
                    for (int j = 0; j < 4; ++j) { const v4u xv = xr[tk + j];
                        acc[0] += wt[j][0] * bf_lo(xv.x); acc[1] += wt[j][1] * bf_hi(xv.x); acc[2] += wt[j][2] * bf_lo(xv.y); acc[3] += wt[j][3] * bf_hi(xv.y);
                        acc[4] += wt[j][4] * bf_lo(xv.z); acc[5] += wt[j][5] * bf_hi(xv.z); acc[6] += wt[j][6] * bf_lo(xv.w); acc[7] += wt[j][7] * bf_hi(xv.w); }
#pragma unroll
                    for (int e = 0; e < 8; ++e) acc[e] = fast_silu(acc[e]) * sc;
                    v4u o; o.x = cvt_pk_bf16(acc[0], acc[1]); o.y = cvt_pk_bf16(acc[2], acc[3]); o.z = cvt_pk_bf16(acc[4], acc[5]); o.w = cvt_pk_bf16(acc[6], acc[7]);
                    *(v4u*)(QA + (size_t)(t0 + tk) * D + col) = o;
                    if (part == 1) { const float wk = wkv[tk]; LAS unsigned* kd = (LAS unsigned*)(KW + (tg * 8 + tk) * P5_KP + cq * 8);
                        kd[0] = cvt_pk_bf16(acc[0] * wk, acc[1] * wk); kd[1] = cvt_pk_bf16(acc[2] * wk, acc[3] * wk); kd[2] = cvt_pk_bf16(acc[4] * wk, acc[5] * wk); kd[3] = cvt_pk_bf16(acc[6] * wk, acc[7] * wk); }
                }
            }
        } else {
#pragma unroll 1
        for (int sub = 0; sub < 2; ++sub) {
            const int lrow = sub * 64 + tl, tok = c * 128 + lrow;
            {
                const int head = mh - 4, d0 = cb * 16;
                const float posf = (float)positions[tok];
                const float lg = logf(1.0f - exp2f(-5.0f - (float)head));
                const float gwt = __expf(lg * (float)(127 - (tok & 127)));
                float cs[16], sn[16];
#pragma unroll
                for (int e = 0; e < 16; ++e) {
                    const float inv = invf[e];
                    const float p = posf * inv, perr = fmaf(posf, inv, -p);
                    const float k = rintf(p * 0.15915494309189535f);
                    float r = fmaf(-k, 6.28125f, p); r += perr; r = fmaf(-k, 0.0019353071795864769f, r);
                    const float rev = r * 0.15915494309189535f;
                    cs[e] = __builtin_amdgcn_cosf(rev); sn[e] = __builtin_amdgcn_sinf(rev);
                }
#pragma unroll
                for (int part = 0; part < 2; ++part) {
                    const int pcol = 2048 + part * 1024 + head * 256 + d0, qcol = 2048 + part * 1024 + head * 256 + d0;
                    const v4u a0 = *(const v4u*)(proj + (size_t)tok * NP + pcol), a1 = *(const v4u*)(proj + (size_t)tok * NP + pcol + 8);
                    const v4u b0 = *(const v4u*)(proj + (size_t)tok * NP + pcol + 128), b1 = *(const v4u*)(proj + (size_t)tok * NP + pcol + 136);
                    float x1[16], x2[16];
                    x1[0] = bf_lo(a0.x); x1[1] = bf_hi(a0.x); x1[2] = bf_lo(a0.y); x1[3] = bf_hi(a0.y); x1[4] = bf_lo(a0.z); x1[5] = bf_hi(a0.z); x1[6] = bf_lo(a0.w); x1[7] = bf_hi(a0.w);
                    x1[8] = bf_lo(a1.x); x1[9] = bf_hi(a1.x); x1[10] = bf_lo(a1.y); x1[11] = bf_hi(a1.y); x1[12] = bf_lo(a1.z); x1[13] = bf_hi(a1.z); x1[14] = bf_lo(a1.w); x1[15] = bf_hi(a1.w);
                    x2[0] = bf_lo(b0.x); x2[1] = bf_hi(b0.x); x2[2] = bf_lo(b0.y); x2[3] = bf_hi(b0.y); x2[4] = bf_lo(b0.z); x2[5] = bf_hi(b0.z); x2[6] = bf_lo(b0.w); x2[7] = bf_hi(b0.w);
                    x2[8] = bf_lo(b1.x); x2[9] = bf_hi(b1.x); x2[10] = bf_lo(b1.y); x2[11] = bf_hi(b1.y); x2[12] = bf_lo(b1.z); x2[13] = bf_hi(b1.z); x2[14] = bf_lo(b1.w); x2[15] = bf_hi(b1.w);
                    const float sc = part == 1 ? 0.0625f : 1.0f;
                    float o1[16], o2[16];
#pragma unroll
                    for (int e = 0; e < 16; ++e) { o1[e] = (x1[e] * cs[e] - x2[e] * sn[e]) * sc; o2[e] = (x2[e] * cs[e] + x1[e] * sn[e]) * sc; }
#pragma unroll
                    for (int e8 = 0; e8 < 2; ++e8) {
                        v4u o; o.x = cvt_pk_bf16(o1[8 * e8], o1[8 * e8 + 1]); o.y = cvt_pk_bf16(o1[8 * e8 + 2], o1[8 * e8 + 3]); o.z = cvt_pk_bf16(o1[8 * e8 + 4], o1[8 * e8 + 5]); o.w = cvt_pk_bf16(o1[8 * e8 + 6], o1[8 * e8 + 7]);
                        *(v4u*)(QA + (size_t)tok * D + qcol + 8 * e8) = o;
                        v4u p; p.x = cvt_pk_bf16(o2[8 * e8], o2[8 * e8 + 1]); p.y = cvt_pk_bf16(o2[8 * e8 + 2], o2[8 * e8 + 3]); p.z = cvt_pk_bf16(o2[8 * e8 + 4], o2[8 * e8 + 5]); p.w = cvt_pk_bf16(o2[8 * e8 + 6], o2[8 * e8 + 7]);
                        *(v4u*)(QA + (size_t)tok * D + qcol + 128 + 8 * e8) = p; }
                    if (part == 1) {
#pragma unroll
                        for (int e = 0; e < 16; e += 2) {
                            *(LAS unsigned*)(KW + lrow * P5_KP + d0 + e) = cvt_pk_bf16(o1[e] * gwt, o1[e + 1] * gwt);
                            *(LAS unsigned*)(KW + lrow * P5_KP + 128 + d0 + e) = cvt_pk_bf16(o2[e] * gwt, o2[e + 1] * gwt); }
                    }
                }
            }
        }
        }
        bf16x8 bfr[4][4];
        { const bf16* vt = VT + (size_t)(mh * 512 + 64 * F.wave + fr) * S + c * 128 + fq * 8;
#pragma unroll
            for (int i = 0; i < 4; ++i)
#pragma unroll
                for (int kk = 0; kk < 4; ++kk) bfr[i][kk] = *(const bf16x8*)(vt + (size_t)(i * 16) * S + 32 * kk); }
        LDS_WAIT(); __syncthreads();
        if (mh < 4 && tu < 256) {
            float rs = 0.f;
#pragma unroll 16
            for (int r = 0; r < 128; ++r) rs += bf2f(KW[r * P5_KP + tu]);
            ((float*)(F.ws + WS_NPREV))[(size_t)(mh * 64 + c) * 256 + tu] = rs;
        }
        bf16* up = U + ((size_t)(mh * 64 + c) * 512 + 64 * F.wave + fr) * 256 + 4 * fq;
#pragma unroll 1
        for (int qd = 0; qd < 4; ++qd) {
            f32x4 acc[4][4];
#pragma unroll
            for (int i = 0; i < 4; ++i)
#pragma unroll
                for (int nn = 0; nn < 4; ++nn) acc[i][nn] = (f32x4){0.f, 0.f, 0.f, 0.f};
#pragma unroll
            for (int nn = 0; nn < 4; ++nn) {
                const LAS bf16* kc = KW + (8 * fq) * P5_KP + 64 * qd + 16 * nn + fr;
#pragma unroll
                for (int kk = 0; kk < 4; ++kk) {
                    bf16x8 af;
#pragma unroll
                    for (int j = 0; j < 8; ++j) af[j] = (short)kc[(32 * kk + j) * P5_KP];
#pragma unroll
                    for (int i = 0; i < 4; ++i) acc[i][nn] = __builtin_amdgcn_mfma_f32_16x16x32_bf16(af, bfr[i][kk], acc[i][nn], 0, 0, 0);
                }
            }
#pragma unroll
            for (int i = 0; i < 4; ++i)
#pragma unroll
                for (int nn = 0; nn < 4; ++nn) { const f32x4 v = acc[i][nn]; v2u o; o.x = cvt_pk_bf16(v[0], v[1]); o.y = cvt_pk_bf16(v[2], v[3]);
                    *(v2u*)(up + (size_t)(i * 16) * 256 + 64 * qd + 16 * nn) = o; }
        }
        __syncthreads();
    }
}

__device__ __forceinline__ float chunk_decay(Frame& F, int mh, int c) {
    if (mh < 4) { const float* MArr = (const float*)(F.ws + WS_MARR) + mh * S; const float mp = c > 0 ? MArr[c * 128 - 1] : 0.f; return __expf(mp - MArr[c * 128 + 127]); }
    return __expf(128.0f * logf(1.0f - exp2f(-5.0f - (float)(mh - 4))));
}
__device__ __forceinline__ void p7_scan(Frame& F) {
    int tz_ = threadIdx.x; asm volatile("" : "+v"(tz_)); const int tid_ = tz_, lane_ = tz_ & 63;
    bf16* U = (bf16*)(F.ws + WS_U);
    const int gid = (F.vcu * NWAVES + F.wave) * 64 + lane_, NT = F.G * NWAVES * 64;
    for (int e = gid; e < 8 * 16384; e += NT) {
        const int mh = e >> 14, rest = e & 16383;
        bf16* p = U + (size_t)(mh * 64) * 131072 + (size_t)rest * 8;
        float st[8];
#pragma unroll
        for (int q = 0; q < 8; ++q) st[q] = 0.f;
#pragma unroll 1
        for (int c0 = 0; c0 < 64; c0 += 8) {
            v4u u[8]; float d[8];
#pragma unroll
            for (int k = 0; k < 8; ++k) u[k] = *(const v4u*)(p + (size_t)(c0 + k) * 131072);
#pragma unroll
            for (int k = 0; k < 8; ++k) d[k] = chunk_decay(F, mh, c0 + k);
#pragma unroll
            for (int k = 0; k < 8; ++k) {
                v4u o; o.x = cvt_pk_bf16(st[0], st[1]); o.y = cvt_pk_bf16(st[2], st[3]); o.z = cvt_pk_bf16(st[4], st[5]); o.w = cvt_pk_bf16(st[6], st[7]);
                *(v4u*)(p + (size_t)(c0 + k) * 131072) = o;
                st[0] = d[k] * st[0] + bf_lo(u[k].x); st[1] = d[k] * st[1] + bf_hi(u[k].x); st[2] = d[k] * st[2] + bf_lo(u[k].y); st[3] = d[k] * st[3] + bf_hi(u[k].y);
                st[4] = d[k] * st[4] + bf_lo(u[k].z); st[5] = d[k] * st[5] + bf_hi(u[k].z); st[6] = d[k] * st[6] + bf_lo(u[k].w); st[7] = d[k] * st[7] + bf_hi(u[k].w);
            }
        }
    }
    if (gid < 1024) {
        const int head = gid >> 8, dk = gid & 255; float sn = 0.f;
        float* np = (float*)(F.ws + WS_NPREV) + (size_t)(head * 64) * 256 + dk;
        for (int c = 0; c < 64; ++c) { const float rs = np[c * 256]; np[c * 256] = sn; sn = chunk_decay(F, head, c) * sn + rs; }
    }
}

constexpr int P8_KP = 264, P8_VP = 136;
constexpr int P8_KS_OFF = 0, P8_PB_OFF = 128 * P8_KP * 2, P8_PB_BYTES = 64 * P8_KP * 2;
static_assert(P8_PB_OFF + 2 * P8_PB_BYTES <= MISC_OFF, "P8 LDS map");
__device__ __forceinline__ void p8_outputs(Frame& F, const Args& a) {
    int tz_ = threadIdx.x; asm volatile("" : "+v"(tz_)); const int tid_ = tz_, lane_ = tz_ & 63;
    const bf16* QA = (const bf16*)(F.ws + WS_QA); const bf16* VT = (const bf16*)(F.ws + WS_VT); const bf16* U = (const bf16*)(F.ws + WS_U); const bf16* proj = (const bf16*)(F.ws + WS_R1);
    const int slab = F.wave;
    LAS unsigned char* KS = F.lds + P8_KS_OFF;
    for (int unit = F.vcu; unit < 512; unit += F.G) {
        int tu = tid_; asm volatile("" : "+v"(tu)); const int fr = tu & 15, fq = (tu & 63) >> 4;
        const int mh = unit >> 6, c = unit & 63, mixer = mh >> 2, head = mh & 3;
        const int j0 = slab * 16 + fr, tok = c * 128 + j0;
        const bf16* ctg = U + (size_t)(mh * 64 + c) * 131072;
        const bf16* vtg = VT + (size_t)(mh * 512) * S + c * 128;
        const int p_first = c > 0 ? 0 : 8;
        {
            const bf16* kg = QA + (size_t)(c * 128) * D + (mixer ? 3072 : 1024) + head * 256;
            v4u kr[8];
#pragma unroll
            for (int i = 0; i < 8; ++i) { const int idx = tu + 512 * i; kr[i] = *(const v4u*)(kg + (size_t)(idx >> 5) * D + (idx & 31) * 8); }
            v4u pr[4];
            if (c > 0) {
#pragma unroll
                for (int i = 0; i < 4; ++i) { const int idx = tu + 512 * i; pr[i] = *(const v4u*)(ctg + (size_t)(idx >> 5) * 256 + (idx & 31) * 8); }
            } else {
#pragma unroll
                for (int i = 0; i < 2; ++i) { const int idx = tu + 512 * i; pr[i] = *(const v4u*)(vtg + (size_t)(idx >> 4) * S + (idx & 15) * 8); }
            }
#pragma unroll
            for (int i = 0; i < 8; ++i) { const int idx = tu + 512 * i; *(LAS v4u*)(KS + (idx >> 5) * (P8_KP * 2) + (idx & 31) * 16) = kr[i]; }
            LAS unsigned char* pb = F.lds + P8_PB_OFF;
            if (c > 0) {
#pragma unroll
                for (int i = 0; i < 4; ++i) { const int idx = tu + 512 * i; *(LAS v4u*)(pb + (idx >> 5) * (P8_KP * 2) + (idx & 31) * 16) = pr[i]; }
            } else {
#pragma unroll
                for (int i = 0; i < 2; ++i) { const int idx = tu + 512 * i; *(LAS v4u*)(pb + (idx >> 4) * (P8_VP * 2) + (idx & 15) * 16) = pr[i]; }
            }
        }
        bf16x8 qf[8];
        { const bf16* qrow = QA + (size_t)tok * D + (mixer ? 2048 : 0) + head * 256 + fq * 8;
#pragma unroll
            for (int kk = 0; kk < 8; ++kk) qf[kk] = *(const bf16x8*)(qrow + 32 * kk); }
        LDS_WAIT(); __syncthreads();
        f32x4 sacc[8];
#pragma unroll
        for (int sb = 0; sb < 8; ++sb) sacc[sb] = (f32x4){0.f, 0.f, 0.f, 0.f};
        { const LAS unsigned char* kb = KS + fr * (P8_KP * 2) + fq * 16;
#pragma unroll
            for (int sb = 0; sb < 8; ++sb) if (sb <= slab) {
                bf16x8 af[8];
#pragma unroll
                for (int kk = 0; kk < 8; ++kk) af[kk] = *(const LAS bf16x8*)(kb + (16 * sb) * (P8_KP * 2) + 64 * kk);
#pragma unroll
                for (int kk = 0; kk < 8; ++kk) sacc[sb] = __builtin_amdgcn_mfma_f32_16x16x32_bf16(af[kk], qf[kk], sacc[sb], 0, 0, 0);
            } }
        float winter, psum = 0.f, Mt = 0.f;
        if (mixer == 0) {
            const float* aArr = (const float*)(F.ws + WS_AARR) + head * S + c * 128; const float* MArr = (const float*)(F.ws + WS_MARR) + head * S;
            Mt = MArr[tok]; const float mp = c > 0 ? MArr[c * 128 - 1] : 0.f; winter = __expf(mp - Mt);
#pragma unroll
            for (int sb = 0; sb < 8; ++sb) { const f32x4 av = *(const f32x4*)(aArr + 16 * sb + 4 * fq);
#pragma unroll
                for (int j = 0; j < 4; ++j) { const int kp = 16 * sb + 4 * fq + j; const float w = kp <= j0 ? __expf(fminf(av[j] - Mt, 0.f)) : 0.f; sacc[sb][j] *= w; psum += sacc[sb][j]; } }
        } else {
            const float lg = logf(1.0f - exp2f(-5.0f - (float)head));
            winter = __expf(lg * (float)(j0 + 1));
#pragma unroll
            for (int sb = 0; sb < 8; ++sb)
#pragma unroll
                for (int j = 0; j < 4; ++j) { const int kp = 16 * sb + 4 * fq + j; const float w = kp <= j0 ? __expf(lg * (float)(j0 - kp)) : 0.f; sacc[sb][j] *= w; }
        }
        bf16x8 pf[4];
#pragma unroll
        for (int ks = 0; ks < 4; ++ks) { v4u w; w.x = cvt_pk_bf16(sacc[2 * ks][0], sacc[2 * ks][1]); w.y = cvt_pk_bf16(sacc[2 * ks][2], sacc[2 * ks][3]);
            w.z = cvt_pk_bf16(sacc[2 * ks + 1][0], sacc[2 * ks + 1][1]); w.w = cvt_pk_bf16(sacc[2 * ks + 1][2], sacc[2 * ks + 1][3]); pf[ks] = __builtin_bit_cast(bf16x8, w); }
        float qn = 0.f;
        if (mixer == 0) {
            if (c > 0) { const float* np = (const float*)(F.ws + WS_NPREV) + (size_t)(head * 64 + c) * 256 + 8 * fq;
#pragma unroll
                for (int kk = 0; kk < 8; ++kk) { const f32x4 n0 = *(const f32x4*)(np + 32 * kk), n1 = *(const f32x4*)(np + 32 * kk + 4); const v4u qw = __builtin_bit_cast(v4u, qf[kk]);
                    qn += (bf_lo(qw.x) * n0.x + bf_hi(qw.x) * n0.y) + (bf_lo(qw.y) * n0.z + bf_hi(qw.y) * n0.w) + (bf_lo(qw.z) * n1.x + bf_hi(qw.z) * n1.y) + (bf_lo(qw.w) * n1.z + bf_hi(qw.w) * n1.w); } }
        }
        f32x4 acc[32];
#pragma unroll
        for (int n = 0; n < 32; ++n) acc[n] = (f32x4){0.f, 0.f, 0.f, 0.f};
#pragma unroll
        for (int p = 0; p < 16; ++p) {
            if (p >= p_first) {
                int tp = tid_; asm volatile("" : "+v"(tp));
                const int tfr = tp & 15, tfq = (tp & 63) >> 4;
                v4u pr[4];
                if (p + 1 < 8) {
#pragma unroll
                    for (int i = 0; i < 4; ++i) { const int idx = tp + 512 * i; pr[i] = *(const v4u*)(ctg + (size_t)(64 * (p + 1) + (idx >> 5)) * 256 + (idx & 31) * 8); }
                } else if (p + 1 < 16) {
#pragma unroll
                    for (int i = 0; i < 2; ++i) { const int idx = tp + 512 * i; pr[i] = *(const v4u*)(vtg + (size_t)(64 * (p + 1 - 8) + (idx >> 4)) * S + (idx & 15) * 8); }
                }
                const LAS unsigned char* pb = F.lds + P8_PB_OFF + (p & 1) * P8_PB_BYTES;
                if (p < 8) {
                    const LAS unsigned char* cb = pb + tfr * (P8_KP * 2) + tfq * 16;
#pragma unroll
                    for (int nn = 0; nn < 4; ++nn) {
                        bf16x8 af[8];
#pragma unroll
                        for (int kk = 0; kk < 8; ++kk) af[kk] = *(const LAS bf16x8*)(cb + (16 * nn) * (P8_KP * 2) + 64 * kk);
#pragma unroll
                        for (int kk = 0; kk < 8; ++kk) acc[4 * p + nn] = __builtin_amdgcn_mfma_f32_16x16x32_bf16(af[kk], qf[kk], acc[4 * p + nn], 0, 0, 0);
                    }
                } else {
                    if (p == 8) {
#pragma unroll
                        for (int n = 0; n < 32; ++n) acc[n] = acc[n] * winter;
                    }
                    const LAS unsigned char* vb = pb + tfr * (P8_VP * 2) + tfq * 8;
#pragma unroll
                    for (int nn = 0; nn < 4; ++nn) {
#pragma unroll
                        for (int ks = 0; ks < 4; ++ks) if (2 * ks <= slab) {
                            const v2u lo = *(const LAS v2u*)(vb + (16 * nn) * (P8_VP * 2) + 64 * ks), hi = *(const LAS v2u*)(vb + (16 * nn) * (P8_VP * 2) + 64 * ks + 32);
                            v4u w; w.x = lo.x; w.y = lo.y; w.z = hi.x; w.w = hi.y;
                            acc[4 * (p - 8) + nn] = __builtin_amdgcn_mfma_f32_16x16x32_bf16(__builtin_bit_cast(bf16x8, w), pf[ks], acc[4 * (p - 8) + nn], 0, 0, 0);
                        }
                    }
                }
                if (p + 1 < 16) {
                    LAS unsigned char* nb = F.lds + P8_PB_OFF + ((p + 1) & 1) * P8_PB_BYTES;
                    if (p + 1 < 8) {
#pragma unroll
                        for (int i = 0; i < 4; ++i) { const int idx = tp + 512 * i; *(LAS v4u*)(nb + (idx >> 5) * (P8_KP * 2) + (idx & 31) * 16) = pr[i]; }
                    } else {
#pragma unroll
                        for (int i = 0; i < 2; ++i) { const int idx = tp + 512 * i; *(LAS v4u*)(nb + (idx >> 4) * (P8_VP * 2) + (idx & 15) * 16) = pr[i]; }
                    }
                    LDS_WAIT(); __syncthreads();
                }
            }
        }
        if (mixer == 0) {
            qn += __shfl_xor(qn, 16); qn += __shfl_xor(qn, 32);
            psum += __shfl_xor(psum, 16); psum += __shfl_xor(psum, 32);
            const float den = psum + winter * qn;
            const float Bm = ((const float*)(F.ws + WS_BMARR))[head * S + tok];
            const float inv = 1.0f / fmaxf(fabsf(den), __expf(-Bm));
#pragma unroll
            for (int n = 0; n < 32; ++n) acc[n] = acc[n] * inv;
        }
        float s1 = 0.f;
#pragma unroll
        for (int n = 0; n < 32; ++n) s1 += (acc[n][0] + acc[n][1]) + (acc[n][2] + acc[n][3]);
        s1 += __shfl_xor(s1, 16); s1 += __shfl_xor(s1, 32);
        const float mean = s1 * (1.0f / 512.0f); float s2 = 0.f;
#pragma unroll
        for (int n = 0; n < 32; ++n) { acc[n] = acc[n] - mean; s2 += (acc[n][0] * acc[n][0] + acc[n][1] * acc[n][1]) + (acc[n][2] * acc[n][2] + acc[n][3] * acc[n][3]); }
        s2 += __shfl_xor(s2, 16); s2 += __shfl_xor(s2, 32);
        const float rstd = 1.0f / sqrtf(s2 * (1.0f / 512.0f) + HEAD_EPS);
        int te = tid_; asm volatile("" : "+v"(te)); const int efq = (te & 63) >> 4, etok = c * 128 + slab * 16 + (te & 15);
        const float* gain = (const float*)a.in[mixer ? 12 : 11] + head * 512 + 4 * efq;
        const bf16* gp = proj + (size_t)etok * NP + (mixer ? 4096 : 6144) + head * 512 + 4 * efq;
        bf16* yp = (bf16*)(F.ws + WS_Y) + (size_t)etok * D + mixer * 2048 + head * 512 + 4 * efq;
#pragma unroll
        for (int n = 0; n < 32; ++n) {
            const f32x4 gn = *(const f32x4*)(gain + 16 * n); const v2u gw2 = *(const v2u*)(gp + 16 * n);
            const float g0 = bf_lo(gw2.x), g1 = bf_hi(gw2.x), g2 = bf_lo(gw2.y), g3 = bf_hi(gw2.y);
            float y0 = acc[n][0] * rstd * gn.x, y1 = acc[n][1] * rstd * gn.y, y2 = acc[n][2] * rstd * gn.z, y3 = acc[n][3] * rstd * gn.w;
            if (mixer == 0) { y0 *= fast_sigmoid(g0); y1 *= fast_sigmoid(g1); y2 *= fast_sigmoid(g2); y3 *= fast_sigmoid(g3); }
            else { y0 *= fast_silu(g0); y1 *= fast_silu(g1); y2 *= fast_silu(g2); y3 *= fast_silu(g3); }
            v2u o; o.x = cvt_pk_bf16(y0, y1); o.y = cvt_pk_bf16(y2, y3);
            *(v2u*)(yp + 16 * n) = o;
        }
        __syncthreads();
    }
}

__global__ void __launch_bounds__(NWAVES * 64, 2) fwd_kernel(Args args) {
    extern __shared__ __attribute__((aligned(16))) unsigned char lds_raw[];
    Frame F;
    F.lds = (LAS unsigned char*)lds_raw; F.ws = args.ws; F.in = nullptr;
    F.tid = threadIdx.x; F.lane = F.tid & 63; F.wave = __builtin_amdgcn_readfirstlane(F.tid >> 6);
    F.G = gridDim.x; { const int bx = blockIdx.x; F.vcu = (F.G % 8 == 0) ? (bx % 8) * (F.G / 8) + bx / 8 : bx; }
    volatile LAS unsigned* MISC = (volatile LAS unsigned*)(F.lds + MISC_OFF);
    for (int u = F.tid; u < 128; u += NWAVES * 64) MISC[u] = 0u;
    __syncthreads();
    const int lo = args.ph_lo, hi = args.ph_hi;
    XcdBarrier bar; bar.bar = (unsigned*)(F.ws + WS_CTL) + CW_BAR; bar.x = 0; bar.st = nullptr;
    if (hi - lo > 1) bar = xcd_barrier_post((unsigned*)(F.ws + WS_CTL) + CW_BAR, MISC + 8);
#ifndef PH_MASK
#define PH_MASK 0xFFFF
#endif
#define IN(k) (((PH_MASK >> (k)) & 1) && lo <= (k) && (k) < hi)
#define SEAM(k) do { if (IN(k) && IN((k) + 1)) xcd_barrier(bar); } while (0)
    LAS unsigned char* ring = F.lds;
    bf16* const XB = (bf16*)(F.ws + WS_XB); bf16* const R1 = (bf16*)(F.ws + WS_R1); float* const T = (float*)(F.ws + WS_T);
    float* const HF = (float*)(F.ws + WS_HF); bf16* const HB = (bf16*)(F.ws + WS_HB);

#ifndef REP_MASK
#define REP_MASK 0
#endif
#define PHASE(k, ...) do { if (IN(k)) { __VA_ARGS__ if ((REP_MASK >> (k)) & 1) { xcd_barrier(bar); __VA_ARGS__ } } SEAM(k); } while (0)
    PHASE(0, { p0_convert(F, args); });
    PHASE(1, { pg8::Gemm g{XB, (const bf16*)(F.ws + WS_WGU1), S, 2 * FF, D}; pg8::StaticOrder so; so.init(S, 2 * FF, F.G, (int)blockIdx.x);
        pg8::EpiSwiGLU E{R1, FF}; pg8::gemm_phase<pg8::EpiSwiGLU, pg8::StaticOrder, true, true>(ring, g, so, E);
        if (F.G == 256 && (int)blockIdx.x >= 192) p0_tiles(F, args, T_WD1_LO, T_WD1_HI, ((int)blockIdx.x - 192) * NWAVES + F.wave, 64 * NWAVES); });
    PHASE(2, { pg8::Gemm g{R1, (const bf16*)(F.ws + WS_WD1), S, D, FF}; pg8::StaticOrder so; so.init(S, D, F.G, (int)blockIdx.x);
        pg8::EpiResid E{(const float*)args.in[0], T, D, ALPHA, 0.5f, (float*)(F.ws + WS_PART)}; pg8::gemm_phase<pg8::EpiResid, pg8::StaticOrder, true, true>(ring, g, so, E); });
    PHASE(3, { ln_phase<1>(F, T, (const float*)args.in[5], (const float*)args.in[6], nullptr, HB, (const float*)args.in[8]); });
    PHASE(4, {
        if (blockIdx.x < 4) gate_scan(F, (int)blockIdx.x);
        { pg8::Gemm g{HB, (const bf16*)(F.ws + WS_WIN), S, 6144, D}; pg8::StaticOrder so; so.init(S, 6144, F.G, (int)blockIdx.x);
          pg8::EpiPlainBf16 E{R1, NP}; pg8::gemm_phase<pg8::EpiPlainBf16, pg8::StaticOrder, true, true>(ring, g, so, E); }
        { pg8::Gemm g{(const bf16*)(F.ws + WS_H8), (const bf16*)(F.ws + WS_W8), S, 10240, D / 2}; pg8::StaticOrder so; so.init(S, 10240, F.G, (int)blockIdx.x);
          pg8::EpiPlainBf16 E{R1 + 6144, NP}; pg8::gemm_phase<pg8::EpiPlainBf16, pg8::StaticOrder, true, true, false, true>(ring, g, so, E); }
        { pg8::Gemm g{(const bf16*)(F.ws + WS_WIN) + (size_t)NP * D, HB, 4096, S, D}; pg8::StaticOrder so; so.init(4096, S, F.G, (int)blockIdx.x);
          pg8::EpiPlainBf16 E{(bf16*)(F.ws + WS_VT), S}; pg8::gemm_phase<pg8::EpiPlainBf16, pg8::StaticOrder, true, true>(ring, g, so, E); }
    });
    PHASE(5, { p5_states(F, args); });
    if (IN(6)) { p7_scan(F); } SEAM(6);
    PHASE(7, { p8_outputs(F, args); });
    PHASE(8, { pg8::Gemm g{(const bf16*)(F.ws + WS_Y), (const bf16*)(F.ws + WS_WPM), S, D, D}; pg8::StaticOrder so; so.init(S, D, F.G, (int)blockIdx.x);
        pg8::EpiMerged E{(bf16*)(F.ws + WS_MRG), R1 + 8192, R1 + 12288, NP, D}; pg8::gemm_phase<pg8::EpiMerged, pg8::StaticOrder, true, true, true>(ring, g, so, E); });
    PHASE(9, { pg8::Gemm g{(const bf16*)(F.ws + WS_MRG), (const bf16*)(F.ws + WS_WO), S, D, D}; pg8::StaticOrder so; so.init(S, D, F.G, (int)blockIdx.x);
        typedef pg8::EpiResidLN<WS_T, WS_HF, WS_STATS, WS_PART> EpiA; EpiA E{F.ws, (const float*)args.in[5], (const float*)args.in[6], 1.0f}; pg8::gemm_phase<EpiA, pg8::StaticOrder, true, true>(ring, g, so, E); });
    PHASE(10, { ln_phase<2>(F, HF, (const float*)args.in[16], (const float*)args.in[17], nullptr, HB, nullptr); });
    PHASE(11, { pg8::Gemm g{HB, (const bf16*)(F.ws + WS_WGU2), S, 2 * FF, D}; pg8::StaticOrder so; so.init(S, 2 * FF, F.G, (int)blockIdx.x);
        pg8::EpiSwiGLU E{R1, FF}; pg8::gemm_phase<pg8::EpiSwiGLU, pg8::StaticOrder, true, true>(ring, g, so, E);
        if (F.G == 256 && (int)blockIdx.x >= 192) p0_tiles(F, args, T_LATE, N_TILES, ((int)blockIdx.x - 192) * NWAVES + F.wave, 64 * NWAVES); });
    PHASE(12, { pg8::Gemm g{R1, (const bf16*)(F.ws + WS_WD2), S, D, FF}; pg8::StaticOrder so; so.init(S, D, F.G, (int)blockIdx.x);
        typedef pg8::EpiResidLN<WS_HF, WS_T, WS_STATS, WS_PART> EpiB; EpiB E{F.ws, (const float*)args.in[16], (const float*)args.in[17], 0.5f}; pg8::gemm_phase<EpiB, pg8::StaticOrder, true, true>(ring, g, so, E); });
    PHASE(13, { ln_phase<3>(F, T, (const float*)args.in[21], (const float*)args.in[22], args.out, nullptr, nullptr); });
#undef PHASE
#ifdef DBG_STOP
    if (lo == 100) {
        const size_t gt = (size_t)blockIdx.x * 512 + threadIdx.x, NT = (size_t)gridDim.x * 512;
        if (DBG_BF16) { const bf16* src = (const bf16*)(F.ws + (size_t)DBG_OFF_MIB * MiB); for (size_t i = gt; i < (size_t)S * D; i += NT) args.out[i] = i < (size_t)DBG_N ? bf2f(src[i]) : 0.f; }
        else { const float* src = (const float*)(F.ws + (size_t)DBG_OFF_MIB * MiB); for (size_t i = gt; i < (size_t)S * D; i += NT) args.out[i] = src[i]; }
    }
#endif
#undef IN
#undef SEAM
}

extern "C" void kernel_launch(void* const* d_in, const int* in_sizes, int n_in, void* d_out, int out_size, void* d_ws, size_t ws_size, hipStream_t stream) {
    static int grid = 0;
    if (grid == 0) {
        if (n_in != 23 || out_size != S * D || ws_size < WS_END2) { fprintf(stderr, "kernel_launch: unexpected problem (n_in %d out %d ws %zu need %zu)\n", n_in, out_size, ws_size, (size_t)WS_END2); grid = -1; return; }
        int dev = 0, cus = 0, per_cu = 0;
        if (hipGetDevice(&dev) != hipSuccess || hipDeviceGetAttribute(&cus, hipDeviceAttributeMultiprocessorCount, dev) != hipSuccess) { grid = -1; return; }
        if (hipFuncSetAttribute((const void*)fwd_kernel, hipFuncAttributeMaxDynamicSharedMemorySize, LDS_BYTES) != hipSuccess) { fprintf(stderr, "kernel_launch: hipFuncSetAttribute failed\n"); grid = -1; return; }
        if (hipOccupancyMaxActiveBlocksPerMultiprocessor(&per_cu, (const void*)fwd_kernel, NWAVES * 64, LDS_BYTES) != hipSuccess || per_cu < 1) { fprintf(stderr, "kernel_launch: occupancy query says %d\n", per_cu); }
        (void)hipGetLastError();
        grid = cus;
    }
    if (grid < 0) return;
    (void)hipMemsetAsync((char*)d_ws + WS_CTL, 0, CTL_ZERO_BYTES, stream);
#ifdef DBG_NANFILL
    (void)hipMemsetAsync((char*)d_ws + CTL_ZERO_BYTES, 0xFF, WS_END2 - CTL_ZERO_BYTES, stream);
#endif
    Args a{};
    for (int i = 0; i < 23; ++i) a.in[i] = d_in[i];
    a.out = (float*)d_out; a.ws = (unsigned char*)d_ws;
#if MK_ONE_LAUNCH
    a.ph_lo = 0; a.ph_hi = NPH;
    hipLaunchKernelGGL(fwd_kernel, dim3(grid), dim3(NWAVES * 64), LDS_BYTES, stream, a);
#else
#ifdef DBG_STOP
    for (int p = 0; p <= DBG_STOP; ++p) { a.ph_lo = p; a.ph_hi = p + 1; hipLaunchKernelGGL(fwd_kernel, dim3(grid), dim3(NWAVES * 64), LDS_BYTES, stream, a); }
    a.ph_lo = 100; a.ph_hi = 101; hipLaunchKernelGGL(fwd_kernel, dim3(grid), dim3(NWAVES * 64), LDS_BYTES, stream, a);
#else
    for (int p = 0; p < NPH; ++p) { a.ph_lo = p; a.ph_hi = p + 1; hipLaunchKernelGGL(fwd_kernel, dim3(grid), dim3(NWAVES * 64), LDS_BYTES, stream, a); }
#endif
#endif
}
```

```cpp
#include <hip/hip_runtime.h>
#include <cstdio>
#include <cstdint>
namespace pg8 {
#define PG8_LAS __attribute__((address_space(3)))
typedef unsigned short bf16_t;
typedef short bf16x8 __attribute__((ext_vector_type(8)));
typedef float f32x4 __attribute__((ext_vector_type(4)));
typedef unsigned u32x4 __attribute__((ext_vector_type(4)));
typedef int v4i32 __attribute__((ext_vector_type(4)));
typedef int v8i32 __attribute__((ext_vector_type(8)));
constexpr int BM = 256, BK = 64, HALF = 128, HTB = HALF * BK * 2  , STAGE_BYTES = 8 * HTB, NXCD = 8, WGM = 8;

__host__ __device__ __forceinline__ int lds_byte(int r, int c) { const int st = (r >> 4) * 2 + (c >> 5), rr = r & 15, cc = c & 31, ob = rr * 64 + cc * 2; return st * 1024 + (ob ^ (((ob >> 9) & 1) << 5)); }
__host__ __device__ __forceinline__ void stage_rc(int b, int& R, int& C) { const int st = b / 1024, sb = b % 1024, swz = sb ^ (((sb >> 9) & 1) << 5); R = (st >> 1) * 16 + swz / 64; C = (st & 1) * 32 + (swz % 64) / 2; }
__host__ __device__ __forceinline__ int perm32(int rho) { const int n = rho >> 4, i = rho & 15; return 8 * (i >> 2) + 4 * n + (i & 3); }

struct Unit { int pm, pn; };
struct Gemm { const bf16_t* A; const bf16_t* Bt; int M, N, K; };

struct StaticOrder {
    int nM, nN, nwg, G, c;
    __host__ __device__ void init(int M, int N, int G_, int c_) { nM = M / BM; nN = N / BM; nwg = nM * nN; G = G_; c = c_; }
    __host__ __device__ bool next(int i, Unit& u) const {
        const long L = (long)i * G + c; if (L >= nwg) return false;
        int wgid = (int)L; { const int q = nwg / NXCD, r = nwg % NXCD, xcd = wgid % NXCD, off = wgid / NXCD; wgid = (xcd < r ? xcd * (q + 1) : r * (q + 1) + (xcd - r) * q) + off; }
        const int nig = WGM * nN, gid = wgid / nig, fm = gid * WGM, gsz = (nM - fm) < WGM ? (nM - fm) : WGM;
        u.pm = fm + ((wgid % nig) % gsz); u.pn = (wgid % nig) / gsz; return true;
    }
    __device__ __forceinline__ void a_ready(const Unit&) const {}
    __device__ __forceinline__ void done(const Unit&) const {}
};
typedef float f32x2c __attribute__((ext_vector_type(2)));
typedef __bf16 bf16x2c __attribute__((ext_vector_type(2)));
__device__ __forceinline__ unsigned cvt_pk_bf16(float lo, float hi) { const f32x2c v = {lo, hi}; const bf16x2c r = __builtin_convertvector(v, bf16x2c); return __builtin_bit_cast(unsigned, r); }
typedef float f32x2 __attribute__((ext_vector_type(2)));
__device__ __forceinline__ float fast_sigmoid(float x) { return __builtin_amdgcn_rcpf(1.0f + __builtin_amdgcn_exp2f(-1.4426950408889634f * x)); }
__device__ __forceinline__ float bf_lo(unsigned w) { return __uint_as_float(w << 16); }
__device__ __forceinline__ float bf_hi(unsigned w) { return __uint_as_float(w & 0xffff0000u); }

struct EpiPlainBf16 {
    static constexpr bool PERM = true, AFTER_DRAIN = false;
    bf16_t* O; int ldc;
    __device__ __forceinline__ void operator()(const f32x4 (&acc)[2][2][4][2], const Unit& u, int wr, int wc, int fr, int fq) const {
        const int row0 = u.pm * BM + wr * 64 + fr; const int col0 = u.pn * BM + wc * 32 + 8 * fq;
#pragma unroll
        for (int ai = 0; ai < 2; ++ai)
#pragma unroll
            for (int m = 0; m < 4; ++m) { bf16_t* rowp = O + (size_t)(row0 + ai * HALF + m * 16) * ldc + col0;
#pragma unroll
                for (int bj = 0; bj < 2; ++bj) { const f32x4 v0 = acc[ai][bj][m][0], v1 = acc[ai][bj][m][1];
                    u32x4 w; w.x = cvt_pk_bf16(v0[0], v0[1]); w.y = cvt_pk_bf16(v0[2], v0[3]); w.z = cvt_pk_bf16(v1[0], v1[1]); w.w = cvt_pk_bf16(v1[2], v1[3]);
                    *(u32x4*)(rowp + bj * HALF) = w; } }
    }
};
struct EpiSwiGLU {
    static constexpr bool PERM = true, AFTER_DRAIN = false;
    bf16_t* H; int ldh;
    __device__ __forceinline__ void operator()(const f32x4 (&acc)[2][2][4][2], const Unit& u, int wr, int wc, int fr, int fq) const {
        const int row0 = u.pm * BM + wr * 64 + fr; const int col0 = u.pn * HALF + wc * 32 + 8 * fq;
#pragma unroll
        for (int ai = 0; ai < 2; ++ai)
#pragma unroll
            for (int m = 0; m < 4; ++m) { bf16_t* rowp = H + (size_t)(row0 + ai * HALF + m * 16) * ldh + col0;
                float o[8];
#pragma unroll
                for (int n = 0; n < 2; ++n)
#pragma unroll
                    for (int j = 0; j < 4; ++j) { const float g = acc[ai][0][m][n][j], up = acc[ai][1][m][n][j]; o[4 * n + j] = g * fast_sigmoid(g) * up; }
                u32x4 w; w.x = cvt_pk_bf16(o[0], o[1]); w.y = cvt_pk_bf16(o[2], o[3]); w.z = cvt_pk_bf16(o[4], o[5]); w.w = cvt_pk_bf16(o[6], o[7]);
                *(u32x4*)rowp = w; }
    }
};
struct EpiResid {
    static constexpr bool PERM = false, AFTER_DRAIN = false;
    const float* base; float* T; int ldc; float alpha, s; float* part;
    __device__ __forceinline__ void operator()(const f32x4 (&acc)[2][2][4][2], const Unit& u, int wr, int wc, int fr, int fq) const {
        const int row0 = u.pm * BM + wr * 64 + fr, col0 = u.pn * BM + wc * 32 + 4 * fq;
#pragma unroll
        for (int ai = 0; ai < 2; ++ai)
#pragma unroll
            for (int m = 0; m < 4; ++m) { const int row = row0 + ai * HALF + m * 16; const size_t off = (size_t)row * ldc + col0; float ps = 0.f, pq = 0.f;
#pragma unroll
                for (int bj = 0; bj < 2; ++bj)
#pragma unroll
                    for (int n = 0; n < 2; ++n) { const f32x4 b = *(const f32x4*)(base + off + bj * HALF + n * 16); const f32x4 o = b * alpha + acc[ai][bj][m][n] * s; *(f32x4*)(T + off + bj * HALF + n * 16) = o;
                        ps += (o[0] + o[1]) + (o[2] + o[3]); pq += (o[0] * o[0] + o[1] * o[1]) + (o[2] * o[2] + o[3] * o[3]); }
                ps += __shfl_xor(ps, 16); ps += __shfl_xor(ps, 32); pq += __shfl_xor(pq, 16); pq += __shfl_xor(pq, 32);
                if (fq == 0) { f32x2 pv; pv.x = ps; pv.y = pq; *(f32x2*)(part + ((size_t)row * 64 + u.pn * 4 + wc) * 2) = pv; } }
    }
};
template <size_t TIN_OFF, size_t TOUT_OFF, size_t STATS_OFF, size_t PART_OFF> struct EpiResidLN {
    static constexpr bool PERM = false, AFTER_DRAIN = false;
    unsigned char* ws; const float* lw; const float* lb; float s;
    __device__ __forceinline__ void operator()(const f32x4 (&acc)[2][2][4][2], const Unit& u, int, int, int, int) const {
        int tz = threadIdx.x; asm volatile("" : "+v"(tz));
        const int wid = tz >> 6, wr = wid >> 2, wc = wid & 3, fr = tz & 15, fq = (tz & 63) >> 4;
        const int row0 = u.pm * BM + wr * 64 + fr, col0 = u.pn * BM + wc * 32 + 4 * fq;
        constexpr int ldc = 4096; constexpr float alpha = 1.1892071150027210667f;
        const float* Tin = (const float*)(ws + TIN_OFF); float* Tout = (float*)(ws + TOUT_OFF); const float* stats = (const float*)(ws + STATS_OFF); float* part = (float*)(ws + PART_OFF);
        f32x4 wv[2][2], bv[2][2];
#pragma unroll
        for (int bj = 0; bj < 2; ++bj)
#pragma unroll
            for (int n = 0; n < 2; ++n) { wv[bj][n] = *(const f32x4*)(lw + col0 + bj * HALF + n * 16) * alpha; bv[bj][n] = *(const f32x4*)(lb + col0 + bj * HALF + n * 16) * alpha; }
#pragma unroll
        for (int ai = 0; ai < 2; ++ai)
#pragma unroll
            for (int m = 0; m < 4; ++m) { const int row = row0 + ai * HALF + m * 16; const size_t off = (size_t)row * ldc + col0;
                const float mean = stats[2 * row], rstd = stats[2 * row + 1]; float ps = 0.f, pq = 0.f;
#pragma unroll
                for (int bj = 0; bj < 2; ++bj)
#pragma unroll
                    for (int n = 0; n < 2; ++n) { const f32x4 t = *(const f32x4*)(Tin + off + bj * HALF + n * 16);
                        const f32x4 o = ((t - mean) * rstd) * wv[bj][n] + bv[bj][n] + acc[ai][bj][m][n] * s; *(f32x4*)(Tout + off + bj * HALF + n * 16) = o;
                        ps += (o[0] + o[1]) + (o[2] + o[3]); pq += (o[0] * o[0] + o[1] * o[1]) + (o[2] * o[2] + o[3] * o[3]); }
                ps += __shfl_xor(ps, 16); ps += __shfl_xor(ps, 32); pq += __shfl_xor(pq, 16); pq += __shfl_xor(pq, 32);
                if (fq == 0) { f32x2 pv; pv.x = ps; pv.y = pq; *(f32x2*)(part + ((size_t)row * 64 + u.pn * 4 + wc) * 2) = pv; } }
    }
};
struct EpiMerged {
    static constexpr bool PERM = true, AFTER_DRAIN = false;
    bf16_t* O; const bf16_t* ga; const bf16_t* gb; int ldg, ldc;
    __device__ __forceinline__ void mid(f32x4 (&acc)[2][2][4][2], const Unit& u, int, int, int, int) const {
        int tz = threadIdx.x; asm volatile("" : "+v"(tz));
        const int wid = tz >> 6, wr = wid >> 2, wc = wid & 3, fr = tz & 15, fq = (tz & 63) >> 4;
        const int row0 = u.pm * BM + wr * 64 + fr; const int col0 = u.pn * BM + wc * 32 + 8 * fq;
#pragma unroll
        for (int ai = 0; ai < 2; ++ai)
#pragma unroll
            for (int m = 0; m < 4; ++m) { const int row = row0 + ai * HALF + m * 16;
#pragma unroll
                for (int bj = 0; bj < 2; ++bj) { const size_t off = (size_t)row * ldg + col0 + bj * HALF;
                    const u32x4 a = *(const u32x4*)(ga + off), b = *(const u32x4*)(gb + off);
                    const unsigned aw[4] = {a.x, a.y, a.z, a.w}, bw[4] = {b.x, b.y, b.z, b.w};
#pragma unroll
                    for (int h = 0; h < 4; ++h) {
                        const float ea0 = __builtin_amdgcn_exp2f(-1.4426950408889634f * bf_lo(aw[h])), ea1 = __builtin_amdgcn_exp2f(-1.4426950408889634f * bf_hi(aw[h]));
                        const float eb0 = __builtin_amdgcn_exp2f(-1.4426950408889634f * bf_lo(bw[h])), eb1 = __builtin_amdgcn_exp2f(-1.4426950408889634f * bf_hi(bw[h]));
                        acc[ai][bj][m][h >> 1][2 * (h & 1)] *= (1.0f + eb0) * __builtin_amdgcn_rcpf(1.0f + ea0);
                        acc[ai][bj][m][h >> 1][2 * (h & 1) + 1] *= (1.0f + eb1) * __builtin_amdgcn_rcpf(1.0f + ea1); }
                }
                asm volatile("" ::: "memory"); }
    }
    __device__ __forceinline__ void operator()(const f32x4 (&acc)[2][2][4][2], const Unit& u, int, int, int, int) const {
        int tz = threadIdx.x; asm volatile("" : "+v"(tz));
        const int wid = tz >> 6, wr = wid >> 2, wc = wid & 3, fr = tz & 15, fq = (tz & 63) >> 4;
        const int row0 = u.pm * BM + wr * 64 + fr; const int col0 = u.pn * BM + wc * 32 + 8 * fq;
#pragma unroll
        for (int ai = 0; ai < 2; ++ai)
#pragma unroll
            for (int m = 0; m < 4; ++m) { const int row = row0 + ai * HALF + m * 16;
#pragma unroll
                for (int bj = 0; bj < 2; ++bj) { const int col = col0 + bj * HALF;
                    const u32x4 g = *(const u32x4*)(gb + (size_t)row * ldg + col);
                    const f32x4 v0 = acc[ai][bj][m][0], v1 = acc[ai][bj][m][1];
                    u32x4 w;
                    w.x = cvt_pk_bf16(fast_sigmoid(bf_lo(g.x)) * v0[0], fast_sigmoid(bf_hi(g.x)) * v0[1]); w.y = cvt_pk_bf16(fast_sigmoid(bf_lo(g.y)) * v0[2], fast_sigmoid(bf_hi(g.y)) * v0[3]);
                    w.z = cvt_pk_bf16(fast_sigmoid(bf_lo(g.z)) * v1[0], fast_sigmoid(bf_hi(g.z)) * v1[1]); w.w = cvt_pk_bf16(fast_sigmoid(bf_lo(g.w)) * v1[2], fast_sigmoid(bf_hi(g.w)) * v1[3]);
                    *(u32x4*)(O + (size_t)row * ldc + col) = w; } }
    }
};

template <class Epi, class Sched, bool ALIGN_EPI = false, bool SP2 = false, bool MID = false, bool FP8 = false>
__device__ __forceinline__ void gemm_phase(PG8_LAS unsigned char* lds, const Gemm g, const Sched& S, const Epi& E) {
    const int tid = threadIdx.x, wid = __builtin_amdgcn_readfirstlane(tid >> 6), lane = tid & 63, wr = wid >> 2, wc = wid & 3, fr = lane & 15, fq = lane >> 4;
    const int K = g.K, nt = K / BK;
    unsigned voffA[2], voffB[2];
#pragma unroll
    for (int i = 0; i < 2; ++i) { int R, C; stage_rc(tid * 16 + i * 8192, R, C); const int Rb = Epi::PERM ? ((R & ~31) + perm32(R & 31)) : R;
        voffA[i] = (unsigned)(R * K + C) * 2u; voffB[i] = (unsigned)(Rb * K + C) * 2u; }
    const size_t kstep = (size_t)(BK * 2);
    const size_t hstep = (size_t)HALF * K * 2;
    const size_t tstep = 2 * hstep;
    const unsigned ldsw = (unsigned)wid * 1024u;
    const int aoff = lds_byte(wr * 64 + fr, fq * 8), boff = lds_byte(wc * 32 + fr, fq * 8);
#define PG8_SA(b, h) (((b) * 2 + (h)) * HTB)
#define PG8_SB(b, h) ((4 + (b) * 2 + (h)) * HTB)
#define PG8_STAGE(bufoff, gbase, voff) do { _Pragma("unroll") for (int _i = 0; _i < 2; ++_i) \
        __builtin_amdgcn_global_load_lds((const unsigned*)((const char*)(gbase) + (voff)[_i]), (PG8_LAS unsigned*)(lds + (bufoff) + ldsw + _i * 8192), 16, 0, 0); } while (0)
#define PG8_LDA(dst, b, h) do { if constexpr (FP8) { _Pragma("unroll") for (int m = 0; m < 4; ++m) dst##8[m] = __builtin_shufflevector(*(const PG8_LAS v4i32*)(lds + PG8_SA(b, h) + aoff + m * 2048), *(const PG8_LAS v4i32*)(lds + PG8_SA(b, h) + aoff + m * 2048 + 1024), 0, 1, 2, 3, 4, 5, 6, 7); } \
    else { _Pragma("unroll") for (int m = 0; m < 4; ++m) _Pragma("unroll") for (int k = 0; k < 2; ++k) dst[m][k] = *(const PG8_LAS bf16x8*)(lds + PG8_SA(b, h) + aoff + m * 2048 + k * 1024); } } while (0)
#define PG8_LDB(dst, b, h) do { if constexpr (FP8) { _Pragma("unroll") for (int n = 0; n < 2; ++n) dst##8[n] = __builtin_shufflevector(*(const PG8_LAS v4i32*)(lds + PG8_SB(b, h) + boff + n * 2048), *(const PG8_LAS v4i32*)(lds + PG8_SB(b, h) + boff + n * 2048 + 1024), 0, 1, 2, 3, 4, 5, 6, 7); } \
    else { _Pragma("unroll") for (int n = 0; n < 2; ++n) _Pragma("unroll") for (int k = 0; k < 2; ++k) dst[n][k] = *(const PG8_LAS bf16x8*)(lds + PG8_SB(b, h) + boff + n * 2048 + k * 1024); } } while (0)
#define PG8_MMA(ai, bj, At, Bt) do { __builtin_amdgcn_s_setprio(1); _Pragma("unroll") for (int m = 0; m < 4; ++m) _Pragma("unroll") for (int n = 0; n < 2; ++n) { \
        if constexpr (FP8) { asm volatile("v_mfma_scale_f32_16x16x128_f8f6f4 %0, %1, %2, %0, %3, %4 op_sel_hi:[0,0,0]" : "+v"(acc[ai][bj][m][n]) : "v"(Bt##8[n]), "v"(At##8[m]), "v"(scl_w), "v"(scl_a)); } \
        else { _Pragma("unroll") for (int k = 0; k < 2; ++k) acc[ai][bj][m][n] = __builtin_amdgcn_mfma_f32_16x16x32_bf16(Bt[n][k], At[m][k], acc[ai][bj][m][n], 0, 0, 0); } } \
        __builtin_amdgcn_s_setprio(0); } while (0)
#define PG8_WAIT_V(n) asm volatile("s_waitcnt vmcnt(" #n ")" ::: "memory")
#define PG8_WAIT_L(n) asm volatile("s_waitcnt lgkmcnt(" #n ")" ::: "memory")
#define PG8_BAR __builtin_amdgcn_s_barrier()
#define PG8_SCHED __builtin_amdgcn_sched_barrier(0)
    Unit cur, nxt; int ui = 0;
    if (!S.next(0, cur)) return;
    f32x4 acc[2][2][4][2];
#pragma unroll
    for (int a = 0; a < 2; ++a)
#pragma unroll
        for (int b = 0; b < 2; ++b)
#pragma unroll
            for (int m = 0; m < 4; ++m)
#pragma unroll
                for (int n = 0; n < 2; ++n) acc[a][b][m][n] = (f32x4){0.f, 0.f, 0.f, 0.f};
    bf16x8 At[4][2], B0[2][2], B1[2][2];
    const int scl_w = 0x79797979, scl_a = 0x7F7F7F7F;
    v8i32 At8[4], B08[2], B18[2];
    const char* cA = (const char*)g.A + (size_t)cur.pm * tstep; const char* cB = (const char*)g.Bt + (size_t)cur.pn * tstep;
    S.a_ready(cur);
    if constexpr (SP2) {
        PG8_STAGE(PG8_SB(0, 0), cB, voffB); PG8_STAGE(PG8_SB(0, 1), cB + hstep, voffB); PG8_STAGE(PG8_SA(0, 0), cA, voffA); PG8_STAGE(PG8_SA(0, 1), cA + hstep, voffA);
        if (wr == 1) PG8_BAR;
        PG8_WAIT_V(2); PG8_BAR;
        PG8_STAGE(PG8_SB(1, 0), cB + kstep, voffB); PG8_STAGE(PG8_SA(1, 0), cA + kstep, voffA); PG8_STAGE(PG8_SB(1, 1), cB + hstep + kstep, voffB);
        PG8_WAIT_V(6); PG8_BAR;
    } else {
        PG8_STAGE(PG8_SB(0, 0), cB, voffB); PG8_STAGE(PG8_SA(0, 0), cA, voffA); PG8_STAGE(PG8_SB(0, 1), cB + hstep, voffB); PG8_STAGE(PG8_SA(0, 1), cA + hstep, voffA);
        if (wr == 1) PG8_BAR;
        PG8_WAIT_V(4); PG8_BAR;
        PG8_STAGE(PG8_SB(1, 0), cB + kstep, voffB); PG8_STAGE(PG8_SA(1, 0), cA + kstep, voffA); PG8_STAGE(PG8_SB(1, 1), cB + hstep + kstep, voffB);
        PG8_WAIT_V(6); PG8_BAR;
    }
    for (;;) {
        const bool has_next = S.next(ui + 1, nxt);
        const char* nA = has_next ? (const char*)g.A + (size_t)nxt.pm * tstep : cA; const char* nB = has_next ? (const char*)g.Bt + (size_t)nxt.pn * tstep : cB;
        for (int hf = 0; hf < (MID ? 2 : 1); ++hf) {
        if constexpr (MID) { if (hf == 1) E.mid(acc, cur, wr, wc, fr, fq); }
        for (int t = MID ? hf * (nt >> 1) : 0; t < (MID ? (hf + 1) * (nt >> 1) : nt); t += 2) {
            const bool last = (t == nt - 2);
            const char* a1 = cA + (size_t)(t + 1) * kstep;
            const char* a2 = last ? nA : cA + (size_t)(t + 2) * kstep; const char* b2 = last ? nB : cB + (size_t)(t + 2) * kstep;
            const char* a3 = a2 + kstep; const char* b3 = b2 + kstep;
            if (last && has_next) S.a_ready(nxt);
            if constexpr (SP2) {
            PG8_LDB(B0, 0, 0); PG8_LDB(B1, 0, 1); PG8_SCHED; PG8_LDA(At, 0, 0); PG8_STAGE(PG8_SA(1, 1), a1 + hstep, voffA);
            PG8_WAIT_V(8); PG8_WAIT_L(0); PG8_BAR; PG8_MMA(0, 0, At, B0); PG8_MMA(0, 1, At, B1); PG8_BAR; PG8_SCHED;
            PG8_LDA(At, 0, 1); PG8_STAGE(PG8_SB(0, 0), b2, voffB); PG8_STAGE(PG8_SB(0, 1), b2 + hstep, voffB); PG8_STAGE(PG8_SA(0, 0), a2, voffA);
            PG8_WAIT_V(8); PG8_WAIT_L(0); PG8_BAR; PG8_MMA(1, 0, At, B0); PG8_MMA(1, 1, At, B1); PG8_BAR; PG8_SCHED;
            PG8_LDB(B0, 1, 0); PG8_LDB(B1, 1, 1); PG8_SCHED; PG8_LDA(At, 1, 0); PG8_STAGE(PG8_SA(0, 1), a2 + hstep, voffA);
            PG8_WAIT_V(8); PG8_WAIT_L(0); PG8_BAR; PG8_MMA(0, 0, At, B0); PG8_MMA(0, 1, At, B1); PG8_BAR; PG8_SCHED;
            PG8_LDA(At, 1, 1); PG8_STAGE(PG8_SB(1, 0), b3, voffB); PG8_STAGE(PG8_SB(1, 1), b3 + hstep, voffB); PG8_STAGE(PG8_SA(1, 0), a3, voffA);
            PG8_WAIT_V(8); PG8_WAIT_L(0); PG8_BAR; PG8_MMA(1, 0, At, B0); PG8_MMA(1, 1, At, B1); PG8_BAR; PG8_SCHED;
            } else {
            PG8_LDB(B0, 0, 0); PG8_SCHED; PG8_LDA(At, 0, 0); PG8_STAGE(PG8_SA(1, 1), a1 + hstep, voffA);
            PG8_WAIT_L(8); PG8_BAR; PG8_WAIT_L(0); PG8_MMA(0, 0, At, B0); PG8_BAR; PG8_SCHED;
            PG8_LDB(B1, 0, 1); PG8_STAGE(PG8_SB(0, 0), b2, voffB);
            PG8_BAR; PG8_WAIT_L(0); PG8_MMA(0, 1, At, B1); PG8_BAR;
            PG8_LDA(At, 0, 1); PG8_STAGE(PG8_SA(0, 0), a2, voffA);
            PG8_BAR; PG8_WAIT_L(0); PG8_MMA(1, 0, At, B0); PG8_BAR; PG8_SCHED;
            PG8_STAGE(PG8_SB(0, 1), b2 + hstep, voffB);
            PG8_WAIT_V(6); PG8_BAR; PG8_MMA(1, 1, At, B1); PG8_BAR;
            PG8_LDB(B0, 1, 0); PG8_SCHED; PG8_LDA(At, 1, 0); PG8_STAGE(PG8_SA(0, 1), a2 + hstep, voffA);
            PG8_WAIT_L(8); PG8_BAR; PG8_WAIT_L(0); PG8_MMA(0, 0, At, B0); PG8_BAR; PG8_SCHED;
            PG8_LDB(B1, 1, 1); PG8_STAGE(PG8_SB(1, 0), b3, voffB);
            PG8_BAR; PG8_WAIT_L(0); PG8_MMA(0, 1, At, B1); PG8_BAR;
            PG8_LDA(At, 1, 1); PG8_STAGE(PG8_SA(1, 0), a3, voffA);
            PG8_BAR; PG8_WAIT_L(0); PG8_MMA(1, 0, At, B0); PG8_BAR; PG8_SCHED;
            PG8_STAGE(PG8_SB(1, 1), b3 + hstep, voffB);
            PG8_WAIT_V(6); PG8_BAR; PG8_MMA(1, 1, At, B1); PG8_BAR;
            }
        }
        }
        if constexpr (FP8) asm volatile("s_nop 15\n\ts_nop 15\n\ts_nop 15" ::: "memory");
        if constexpr (ALIGN_EPI) { if (wr == 0) PG8_BAR; }
        if constexpr (!Epi::AFTER_DRAIN) { E(acc, cur, wr, wc, fr, fq); S.done(cur); }
        if (!has_next) break;
#pragma unroll
        for (int a = 0; a < 2; ++a)
#pragma unroll
            for (int b = 0; b < 2; ++b)
#pragma unroll
                for (int m = 0; m < 4; ++m)
#pragma unroll
                    for (int n = 0; n < 2; ++n) acc[a][b][m][n] = (f32x4){0.f, 0.f, 0.f, 0.f};
        cur = nxt; cA = nA; cB = nB; ++ui;
        if constexpr (ALIGN_EPI) { if (wr == 1) PG8_BAR; }
    }
    PG8_WAIT_V(0);
    if constexpr (!ALIGN_EPI) { if (wr == 0) PG8_BAR; }
    PG8_BAR;
    if constexpr (Epi::AFTER_DRAIN) { E.fused(acc, cur, wr, wc, fr, fq, lds, wid, lane); S.done(cur); }
#undef PG8_SA
#undef PG8_SB
#undef PG8_STAGE
#undef PG8_LDA
#undef PG8_LDB
#undef PG8_MMA
#undef PG8_WAIT_V
#undef PG8_WAIT_L
#undef PG8_BAR
#undef PG8_SCHED
}
}

constexpr int NWAVES = 8;
constexpr int S = 8192, D = 4096, FF = 11008, DIN = 20488, NP = 16384;
constexpr int NPH = 14;
#ifndef MK_ONE_LAUNCH
#define MK_ONE_LAUNCH 1
#endif
constexpr float ALPHA = 1.1892071150027210667f;
constexpr float LN_EPS = 1e-5f, HEAD_EPS = 1e-6f;

constexpr size_t MiB = 1u << 20, KiB = 1u << 10;
constexpr size_t WS_CTL = 0, CTL_ZERO_BYTES = 1 * MiB;
constexpr size_t WS_WIF = 1 * MiB;
constexpr size_t WS_GATES = WS_WIF + 128 * KiB;
constexpr size_t WS_AARR = WS_GATES + 256 * KiB;
constexpr size_t WS_MARR = WS_AARR + 128 * KiB;
constexpr size_t WS_BMARR = WS_MARR + 128 * KiB;
constexpr size_t WS_NPREV = WS_BMARR + 128 * KiB;
constexpr size_t WS_WGU1 = 4 * MiB;
constexpr size_t WS_WD1 = WS_WGU1 + 172 * MiB;
constexpr size_t WS_WIN = WS_WD1 + 86 * MiB;
constexpr size_t WS_WPM = WS_WIN + 160 * MiB;
constexpr size_t WS_WPR = WS_WPM + 16 * MiB;
constexpr size_t WS_WO = WS_WPR + 16 * MiB;
constexpr size_t WS_WGU2 = WS_WO + 32 * MiB;
constexpr size_t WS_WD2 = WS_WGU2 + 172 * MiB;
constexpr size_t WS_R1 = WS_WD2 + 86 * MiB;
constexpr size_t WS_T = WS_R1 + 256 * MiB;
constexpr size_t WS_HF = WS_T + 128 * MiB;
constexpr size_t WS_HB = WS_HF + 128 * MiB;
constexpr size_t WS_XB = WS_HB + 64 * MiB;
constexpr size_t WS_END = WS_XB + 64 * MiB;
constexpr size_t WS_VT = WS_WGU1;
constexpr size_t WS_U = WS_END;
constexpr size_t WS_END2 = WS_U + 128 * MiB;
constexpr size_t WS_QA = WS_WGU1 + 64 * MiB;
constexpr size_t WS_STATS = 2 * MiB;
constexpr size_t WS_PART = WS_WGU1 + 128 * MiB;
constexpr size_t WS_KTW = WS_T + 64 * MiB;
constexpr size_t WS_Y = WS_HB;
constexpr size_t WS_MRG = WS_XB;
constexpr size_t WS_H8 = WS_XB;
constexpr size_t WS_W8 = WS_WIN + (size_t)6144 * 4096 * 2;
constexpr int CW_BAR = 4096;

constexpr int LDS_BYTES = 147456;
constexpr int MISC_OFF = LDS_BYTES - 512;

#define GAS __attribute__((address_space(1)))
#define LAS __attribute__((address_space(3)))
typedef unsigned short bf16;
typedef unsigned v4u __attribute__((ext_vector_type(4)));
typedef unsigned v2u __attribute__((ext_vector_type(2)));
typedef float f32x4 __attribute__((ext_vector_type(4)));
typedef short bf16x8 __attribute__((ext_vector_type(8)));
typedef float f32x2q __attribute__((ext_vector_type(2)));
#define LDS_WAIT() asm volatile("s_waitcnt lgkmcnt(0)" ::: "memory")
#define VM_WAIT() asm volatile("s_waitcnt vmcnt(0)" ::: "memory")
using pg8::cvt_pk_bf16; using pg8::bf_lo; using pg8::bf_hi; using pg8::fast_sigmoid;

#define XB_TMO      128
#define XB_XCNT(j)  (256  + 64 * (j))
#define XB_XSUB(j)  (1280 + 64 * (j))
#define XB_XGEN(j)  (2304 + 64 * (j))
#define XB_TOP      3328
#define XB_TOPGEN   3392
#define XCD_BAR_WORDS 3456
#define XB_SPIN_CAP (1u << 22)

__device__ __forceinline__ unsigned xb_ld(unsigned* p)              { return __hip_atomic_load(p, __ATOMIC_RELAXED, __HIP_MEMORY_SCOPE_AGENT); }
__device__ __forceinline__ unsigned xb_add(unsigned* p, unsigned v) { return __hip_atomic_fetch_add(p, v, __ATOMIC_RELAXED, __HIP_MEMORY_SCOPE_AGENT); }
__device__ __forceinline__ unsigned xb_xcc_id() { return (unsigned)__builtin_amdgcn_s_getreg((3 << 11) | 20) & 0xFu; }
#define XB_SPIN(cond, bar) do { unsigned _sp = 0; while (cond) { __builtin_amdgcn_s_sleep(1); \
    if ((++_sp & 255u) == 0u) { if (xb_ld(&(bar)[XB_TMO])) break; if (_sp > XB_SPIN_CAP) { atomicAdd(&(bar)[XB_TMO], 1u); break; } } } } while (0)

struct XcdBarrier {
    unsigned* bar; unsigned x;
    volatile LAS unsigned* st;
};

__device__ __forceinline__ XcdBarrier xcd_barrier_post(unsigned* bar, volatile LAS unsigned* st) {
    XcdBarrier b; b.bar = bar; b.x = xb_xcc_id(); b.st = st;
    if (threadIdx.x == 0) (void)xb_add(&bar[XB_XCNT(b.x)], 1u);
    return b;
}
__device__ __forceinline__ void xcd_barrier_complete(unsigned* bar, unsigned x, unsigned& nloc, unsigned& nx) {
    const unsigned G = gridDim.x * gridDim.y * gridDim.z;
    unsigned sum, cnt, mine, sp = 0u;
    for (;;) {
        sum = 0u; cnt = 0u; mine = 0u;
#pragma unroll
        for (unsigned j = 0; j < 16; ++j) { const unsigned c = xb_ld(&bar[XB_XCNT(j)]); sum += c; cnt += (c > 0u) ? 1u : 0u; mine = (j == x) ? c : mine; }
        if (sum == G) break;
        __builtin_amdgcn_s_sleep(1);
        if ((++sp & 255u) == 0u) { if (xb_ld(&bar[XB_TMO])) break; if (sp > XB_SPIN_CAP) { atomicAdd(&bar[XB_TMO], 1u); break; } }
    }
    nloc = mine > 0u ? mine : 1u; nx = cnt > 0u ? cnt : 1u;
}

__device__ __forceinline__ void xcd_barrier(const XcdBarrier& b) {
    asm volatile("s_waitcnt vmcnt(0)" ::: "memory");
    __syncthreads();
    if (threadIdx.x == 0) {
        unsigned* bar = b.bar;
        __builtin_amdgcn_s_waitcnt(0);
        unsigned nloc = b.st[0], nx = b.st[1];
        if (nloc == 0u) { xcd_barrier_complete(bar, b.x, nloc, nx); b.st[0] = nloc; b.st[1] = nx; }
        const unsigned old = xb_add(&bar[XB_XSUB(b.x)], 1u);
        const unsigned gen = old / nloc;
        if (old + 1u == (gen + 1u) * nloc) {
            __builtin_amdgcn_fence(__ATOMIC_RELEASE, "agent");
            asm volatile("s_waitcnt vmcnt(0)" ::: "memory");
            const unsigned og = xb_add(&bar[XB_TOP], 1u);
            const unsigned tg = og / nx;
            if (og + 1u == (tg + 1u) * nx) xb_add(&bar[XB_TOPGEN], 1u);
            else XB_SPIN(xb_ld(&bar[XB_TOPGEN]) == tg, bar);
            __builtin_amdgcn_fence(__ATOMIC_ACQUIRE, "agent");
            xb_add(&bar[XB_XGEN(b.x)], 1u);
            asm volatile("s_waitcnt vmcnt(0)" ::: "memory");
        } else {
            XB_SPIN(xb_ld(&bar[XB_XGEN(b.x)]) == gen, bar);
            __builtin_amdgcn_fence(__ATOMIC_ACQUIRE, "agent");
            asm volatile("s_waitcnt vmcnt(0)" ::: "memory");
        }
    }
    __syncthreads();
}

__device__ __forceinline__ float wave_sum(float v) {
#pragma unroll
    for (int o = 1; o < 64; o <<= 1) v += __shfl_xor(v, o);
    return v;
}
__device__ __forceinline__ float bf2f(unsigned short b) { return __uint_as_float(((unsigned)b) << 16); }
__device__ __forceinline__ float fast_silu(float x) { return x * fast_sigmoid(x); }

struct Frame {
    LAS unsigned char* lds;
    unsigned char* ws;
    const void* const* in;
    int tid, lane, wave, vcu, G;
};

struct Seg { int in_idx, ldw, col0, ntn, ldt, row0, map, dst_mib, tile_end, koff; };
__constant__ Seg c_segs[16] = {
    { 2, FF, 0, 172, D, 0, 1, (int)(WS_WGU1 / MiB), 11008, 0},
    { 3, FF, 0, 172, D, 0, 2, (int)(WS_WGU1 / MiB), 22016, 0},
    { 4, D, 0, 64, FF, 0, 0, (int)(WS_WD1 / MiB), 33024, 0},
    { 7, DIN, 0, 32, D, 0, 0, (int)(WS_WIN / MiB), 35072, 0},
    { 7, DIN, 4096, 32, D, 0, 3, (int)(WS_WIN / MiB), 37120, 0},
    { 7, DIN, 6152, 32, D, 2048, 0, (int)(WS_WIN / MiB), 39168, 0},
    { 7, DIN, 10248, 32, D, 4096, 0, (int)(WS_WIN / MiB), 41216, 0},
    { 7, DIN, 12296, 128, D, 2048, 3, (int)(WS_WIN / MiB), 49408, 0},
    { 7, DIN, 2048, 32, D, 16384, 0, (int)(WS_WIN / MiB), 51456, 0},
    { 7, DIN, 8200, 32, D, 18432, 0, (int)(WS_WIN / MiB), 53504, 0},
    {13, D, 0, 64, D, 0, 0, (int)(WS_WPM / MiB), 55552, 0},
    {14, D, 0, 64, D, 0, 0, (int)(WS_WPM / MiB), 57600, 2048},
    {15, D, 0, 64, D, 0, 0, (int)(WS_WO / MiB), 61696, 0},
    {18, FF, 0, 172, D, 0, 1, (int)(WS_WGU2 / MiB), 72704, 0},
    {19, FF, 0, 172, D, 0, 2, (int)(WS_WGU2 / MiB), 83712, 0},
    {20, D, 0, 64, FF, 0, 0, (int)(WS_WD2 / MiB), 94720, 0},
};
constexpr int N_TILES = 94720;

struct Args { const void* in[23]; float* out; unsigned char* ws; int ph_lo, ph_hi; };

struct TileDesc { const float* p; bf16* d; int ldw, ldt, fp8; };
__device__ __forceinline__ TileDesc p0_decode(const Args& a, unsigned char* ws, int it, int lane) {
    int si = 0;
#pragma unroll
    for (int q = 0; q < 15; ++q) si += (it >= c_segs[q].tile_end) ? 1 : 0;
    const Seg sg = c_segs[si];
    const int t = it - (si ? c_segs[si - 1].tile_end : 0);
    const int kg = 4;
    const int g4 = t / (kg * sg.ntn), rem = t - g4 * kg * sg.ntn, nb = rem / kg, kb = kg * g4 + (rem - nb * kg);
    const int n0 = 64 * nb;
    int r0 = sg.row0 + n0;
    if (sg.map == 1 || sg.map == 2) r0 = (n0 >> 7) * 256 + (n0 & 127) + (sg.map == 2 ? 128 : 0);
    TileDesc td;
    td.ldw = sg.ldw; td.ldt = sg.ldt; td.fp8 = sg.map == 3;
    if (sg.map == 3) {
        td.p = (const float*)a.in[sg.in_idx] + (size_t)(64 * kb + 4 * (lane >> 4)) * sg.ldw + sg.col0 + n0 + 4 * (lane & 15);
        td.d = (bf16*)(ws + WS_W8 + (size_t)(sg.row0 + n0 + (lane >> 2)) * 4096 + 64 * kb + 16 * (lane & 3));
        return td;
    }
    td.p = (const float*)a.in[sg.in_idx] + (size_t)(64 * kb + 2 * (lane >> 4)) * sg.ldw + sg.col0 + n0 + 4 * (lane & 15);
    td.d = (bf16*)(ws + (size_t)sg.dst_mib * MiB) + (size_t)(r0 + (lane >> 3)) * sg.ldt + sg.koff + 64 * kb + 8 * (lane & 7);
    return td;
}
__device__ __forceinline__ void p0_load(const TileDesc& td, f32x4 (&v)[16]) {
    if (td.fp8) {
#pragma unroll
        for (int i = 0; i < 4; ++i)
#pragma unroll
            for (int e = 0; e < 4; ++e) v[4 * i + e] = __builtin_nontemporal_load((const f32x4*)(td.p + (size_t)(16 * i + e) * td.ldw));
        return;
    }
#pragma unroll
    for (int i = 0; i < 8; ++i) { v[2 * i] = __builtin_nontemporal_load((const f32x4*)(td.p + (size_t)(8 * i) * td.ldw)); v[2 * i + 1] = __builtin_nontemporal_load((const f32x4*)(td.p + (size_t)(8 * i + 1) * td.ldw)); }
}
__device__ __forceinline__ unsigned pack4_fp8(float a, float b, float c, float d) { int w = 0; w = __builtin_amdgcn_cvt_pk_fp8_f32(a, b, w, false); w = __builtin_amdgcn_cvt_pk_fp8_f32(c, d, w, true); return (unsigned)w; }
__device__ __forceinline__ void p0_store(const TileDesc& td, const f32x4 (&v)[16], LAS unsigned* scr, int lane) {
    const int q = lane & 15, r = lane >> 4;
    if (td.fp8) {
#pragma unroll
        for (int i = 0; i < 4; ++i) { LAS unsigned* s = scr + (4 * q) * 16 + 4 * (i ^ (q & 3)) + r;
            s[0] = pack4_fp8(v[4 * i].x * 64.f, v[4 * i + 1].x * 64.f, v[4 * i + 2].x * 64.f, v[4 * i + 3].x * 64.f);
            s[16] = pack4_fp8(v[4 * i].y * 64.f, v[4 * i + 1].y * 64.f, v[4 * i + 2].y * 64.f, v[4 * i + 3].y * 64.f);
            s[32] = pack4_fp8(v[4 * i].z * 64.f, v[4 * i + 1].z * 64.f, v[4 * i + 2].z * 64.f, v[4 * i + 3].z * 64.f);
            s[48] = pack4_fp8(v[4 * i].w * 64.f, v[4 * i + 1].w * 64.f, v[4 * i + 2].w * 64.f, v[4 * i + 3].w * 64.f); }
        LDS_WAIT();
        const int g = lane & 3;
#pragma unroll
        for (int j = 0; j < 4; ++j) { const int n = (lane >> 2) + 16 * j;
            const v4u o = *(const LAS v4u*)(scr + n * 16 + 4 * (g ^ ((n >> 2) & 3)));
            __builtin_nontemporal_store(o, (v4u*)((unsigned char*)td.d + (size_t)(16 * j) * 4096)); }
        LDS_WAIT();
        return;
    }
#pragma unroll
    for (int i = 0; i < 8; ++i) { LAS unsigned* s = scr + (4 * q) * 32 + 4 * (i ^ (q & 7)) + r;
        s[0] = cvt_pk_bf16(v[2 * i].x, v[2 * i + 1].x); s[32] = cvt_pk_bf16(v[2 * i].y, v[2 * i + 1].y); s[64] = cvt_pk_bf16(v[2 * i].z, v[2 * i + 1].z); s[96] = cvt_pk_bf16(v[2 * i].w, v[2 * i + 1].w); }
    LDS_WAIT();
    const int g = lane & 7;
#pragma unroll
    for (int j = 0; j < 8; ++j) { const int n = (lane >> 3) + 8 * j;
        const v4u o = *(const LAS v4u*)(scr + n * 32 + 4 * (g ^ ((n >> 2) & 7)));
        __builtin_nontemporal_store(o, (v4u*)(td.d + (size_t)(8 * j) * td.ldt)); }
    LDS_WAIT();
}

__device__ __forceinline__ void p0_tiles(Frame& F, const Args& a, int t_lo, int t_hi, int gw, int ngw) {
    int tz_ = threadIdx.x; asm volatile("" : "+v"(tz_)); const int lane_ = tz_ & 63;
    LAS unsigned* scr = (LAS unsigned*)(F.lds + F.wave * 8192);
    f32x4 va[16], vb[16], vc[16];
    TileDesc da, db, dc;
    const int it0 = t_lo + gw;
    da = p0_decode(a, F.ws, it0 < t_hi ? it0 : t_lo, lane_); db = da; dc = da;
    if (it0 < t_hi) p0_load(da, va);
    if (it0 + ngw < t_hi) { db = p0_decode(a, F.ws, it0 + ngw, lane_); p0_load(db, vb); }
    for (int it = it0; it < t_hi; it += 3 * ngw) {
        if (it + 2 * ngw < t_hi) { dc = p0_decode(a, F.ws, it + 2 * ngw, lane_); p0_load(dc, vc); }
        p0_store(da, va, scr, lane_);
        if (it + 3 * ngw < t_hi) { da = p0_decode(a, F.ws, it + 3 * ngw, lane_); p0_load(da, va); }
        if (it + ngw < t_hi) p0_store(db, vb, scr, lane_);
        if (it + 4 * ngw < t_hi) { db = p0_decode(a, F.ws, it + 4 * ngw, lane_); p0_load(db, vb); }
        if (it + 2 * ngw < t_hi) p0_store(dc, vc, scr, lane_);
    }
}
constexpr int T_WD1_LO = 22016, T_WD1_HI = 33024;
constexpr int T_LATE = 83712;
__device__ __forceinline__ void p0_convert(Frame& F, const Args& a) {
    int tz_ = threadIdx.x; asm volatile("" : "+v"(tz_)); const int lane_ = tz_ & 63;
    p0_tiles(F, a, 0, T_WD1_LO, F.vcu * NWAVES + F.wave, F.G * NWAVES);
    p0_tiles(F, a, F.G == 256 ? T_WD1_HI : T_WD1_LO, F.G == 256 ? T_LATE : N_TILES, F.vcu * NWAVES + F.wave, F.G * NWAVES);
    const int gt = (F.vcu * NWAVES + F.wave) * 64 + lane_, NGT = F.G * NWAVES * 64;
    if (gt < 8 * D) { const int g = gt >> 12, k = gt & (D - 1); ((float*)(F.ws + WS_WIF))[gt] = ((const float*)a.in[7])[(size_t)k * DIN + 6144 + g]; }
    const float* x = (const float*)a.in[0]; bf16* xb = (bf16*)(F.ws + WS_XB);
    for (size_t i = (size_t)gt * 8; i < (size_t)S * D; i += (size_t)NGT * 8) {
        const f32x4 u0 = *(const f32x4*)(x + i), u1 = *(const f32x4*)(x + i + 4);
        v4u o; o.x = cvt_pk_bf16(u0.x, u0.y); o.y = cvt_pk_bf16(u0.z, u0.w); o.z = cvt_pk_bf16(u1.x, u1.y); o.w = cvt_pk_bf16(u1.z, u1.w);
        *(v4u*)(xb + i) = o;
    }
}

template <int MODE> __device__ __forceinline__ void ln_phase(Frame& F, const float* __restrict__ T, const float* __restrict__ w, const float* __restrict__ b,
                                                             float* __restrict__ OF, bf16* __restrict__ OB, const float* __restrict__ if_bias) {
    int tz_ = threadIdx.x; asm volatile("" : "+v"(tz_)); const int tid_ = tz_, lane_ = tz_ & 63;
    if (MODE == 1) {
        const v4u* srcw = (const v4u*)(F.ws + WS_WIF); LAS v4u* dl = (LAS v4u*)F.lds;
        for (int i = tid_; i < 8192; i += NWAVES * 64) dl[i] = srcw[i];
        LDS_WAIT(); __syncthreads();
    }
    const int gw = F.vcu * NWAVES + F.wave, NGW = F.G * NWAVES;
    const f32x4* w4 = (const f32x4*)w + lane_; const f32x4* b4 = (const f32x4*)b + lane_;
    const LAS f32x4* wl = (const LAS f32x4*)F.lds + lane_;
    for (int row0 = gw; row0 < S; row0 += 2 * NGW) {
        const int rowv[2] = {row0, row0 + NGW < S ? row0 + NGW : row0};
        const f32x4* xr[2]; float mean[2], rstd[2];
#pragma unroll
        for (int u = 0; u < 2; ++u) {
            xr[u] = (const f32x4*)(T + (size_t)rowv[u] * D) + lane_;
            const f32x2q pv = ((const f32x2q*)(F.ws + WS_PART))[(size_t)rowv[u] * 64 + lane_];
            const float s = wave_sum(pv.x), ss = wave_sum(pv.y);
            mean[u] = s * (1.f / D);
            rstd[u] = 1.f / sqrtf(fmaxf(ss * (1.f / D) - mean[u] * mean[u], 0.f) + LN_EPS);
            if (MODE != 3 && lane_ == 0) { float* st = (float*)(F.ws + WS_STATS) + 2 * rowv[u]; st[0] = mean[u]; st[1] = rstd[u]; }
        }
        float g[2][8];
#pragma unroll
        for (int u = 0; u < 2; ++u)
#pragma unroll
            for (int q = 0; q < 8; ++q) g[u][q] = 0.f;
        constexpr int LN_UNR = MODE == 1 ? 2 : 4;
#pragma unroll LN_UNR
        for (int j = 0; j < 16; ++j) {
            const f32x4 wj = w4[64 * j], bj = b4[64 * j];
            f32x4 y[2];
#pragma unroll
            for (int u = 0; u < 2; ++u) {
                y[u] = (xr[u][64 * j] - mean[u]) * rstd[u] * wj + bj;
                if (MODE == 3) ((f32x4*)(OF + (size_t)rowv[u] * D) + lane_)[64 * j] = y[u];
                if (MODE != 3) { v2u o; o.x = cvt_pk_bf16(y[u].x, y[u].y); o.y = cvt_pk_bf16(y[u].z, y[u].w); ((v2u*)(OB + (size_t)rowv[u] * D) + lane_)[64 * j] = o; }
                if (MODE == 1) ((unsigned*)(F.ws + WS_H8 + (size_t)rowv[u] * D))[lane_ + 64 * j] = pack4_fp8(y[u].x, y[u].y, y[u].z, y[u].w);
            }
            if (MODE == 1) {
#pragma unroll
                for (int q = 0; q < 8; ++q) { const f32x4 ww = wl[q * 1024 + 64 * j];
#pragma unroll
                    for (int u = 0; u < 2; ++u) g[u][q] += (y[u].x * ww.x + y[u].y * ww.y) + (y[u].z * ww.z + y[u].w * ww.w); }
            }
        }
        if (MODE == 1) {
#pragma unroll
            for (int u = 0; u < 2; ++u) {
#pragma unroll
                for (int q = 0; q < 8; ++q) g[u][q] = wave_sum(g[u][q]);
                if (lane_ == 0) { float* go = (float*)(F.ws + WS_GATES) + (size_t)rowv[u] * 8;
#pragma unroll
                    for (int q = 0; q < 8; ++q) go[q] = g[u][q] + if_bias[q]; }
            }
        }
    }
}

__device__ __forceinline__ float log_sigmoid(float x) { return fminf(x, 0.f) - log1pf(expf(-fabsf(x))); }
__device__ __forceinline__ void gate_scan(Frame& F, int head) {
    int tz_ = threadIdx.x; asm volatile("" : "+v"(tz_)); const int tid_ = tz_, lane_ = tz_ & 63;
    const float* gates = (const float*)(F.ws + WS_GATES);
    float* aArr = (float*)(F.ws + WS_AARR) + head * S; float* MArr = (float*)(F.ws + WS_MARR) + head * S; float* BmArr = (float*)(F.ws + WS_BMARR) + head * S;
    LAS float* sc = (LAS float*)F.lds;
    const int t0 = tid_ * 16;
    float lf[16], iv[16];
    float run = 0.f;
    {
        LAS float* gl = sc + 64;
        const f32x4* g4 = (const f32x4*)gates;
#pragma unroll 8
        for (int k = 0; k < 32; ++k) { const int q = tid_ + 512 * k; const f32x4 v = g4[q]; gl[(q & 1) * S + (q >> 1)] = v[head]; }
        LDS_WAIT(); __syncthreads();
#pragma unroll
        for (int j = 0; j < 16; ++j) { iv[j] = gl[t0 + j]; run += log_sigmoid(gl[S + t0 + j]); lf[j] = run; }
    }
    float incl = run;
#pragma unroll
    for (int o = 1; o < 64; o <<= 1) { const float u = __shfl_up(incl, o); if (lane_ >= o) incl += u; }
    if (lane_ == 63) sc[F.wave] = incl;
    LDS_WAIT(); __syncthreads();
    float woff = 0.f;
    for (int w = 0; w < F.wave; ++w) woff += sc[w];
    const float excl = woff + incl - run;
    float mx = -INFINITY;
#pragma unroll
    for (int j = 0; j < 16; ++j) { const float B = excl + lf[j]; const float av = iv[j] - B; mx = fmaxf(mx, av); aArr[t0 + j] = av; lf[j] = B; iv[j] = mx; }
    float im = mx;
#pragma unroll
    for (int o = 1; o < 64; o <<= 1) { const float u = __shfl_up(im, o); if (lane_ >= o) im = fmaxf(im, u); }
    if (lane_ == 63) sc[16 + F.wave] = im;
    LDS_WAIT(); __syncthreads();
    float wm = -INFINITY;
    for (int w = 0; w < F.wave; ++w) wm = fmaxf(wm, sc[16 + w]);
    float prev = __shfl_up(im, 1); if (lane_ == 0) prev = -INFINITY;
    const float em = fmaxf(wm, prev);
#pragma unroll
    for (int j = 0; j < 16; ++j) { const float M = fmaxf(0.f, fmaxf(em, iv[j])); MArr[t0 + j] = M; BmArr[t0 + j] = lf[j] + M; }
    __syncthreads();
}

constexpr int P5_KP = 258;
__device__ __forceinline__ void p5_states(Frame& F, const Args& a) {
    int tz_ = threadIdx.x; asm volatile("" : "+v"(tz_)); const int tid_ = tz_;
    const bf16* proj = (const bf16*)(F.ws + WS_R1); bf16* QA = (bf16*)(F.ws + WS_QA); const bf16* VT = (const bf16*)(F.ws + WS_VT); bf16* U = (bf16*)(F.ws + WS_U);
    const float* convw = (const float*)a.in[9]; const float* convb = (const float*)a.in[10]; const int* positions = (const int*)a.in[1];
    LAS bf16* KW = (LAS bf16*)F.lds;
    float invf[16];
#pragma unroll
    for (int e = 0; e < 16; ++e) invf[e] = exp2f(-(float)((tid_ & 7) * 16 + e) * (13.287712379549449f / 128.0f));
    for (int unit = F.vcu; unit < 512; unit += F.G) {
        int tu = tid_; asm volatile("" : "+v"(tu));
        const int tl = tu >> 3, cb = tu & 7, fr = tu & 15, fq = (tu & 63) >> 4;
        const int mh = unit >> 6, c = unit & 63;
        if (mh < 4) {
            const int head = mh, tg = tu >> 5, cq = tu & 31, t0 = c * 128 + tg * 8;
            float wkv[8];
            { const float* aA = (const float*)(F.ws + WS_AARR) + head * S + t0; const float Mend = ((const float*)(F.ws + WS_MARR))[head * S + c * 128 + 127];
                const f32x4 a0 = *(const f32x4*)aA, a1 = *(const f32x4*)(aA + 4);
                wkv[0] = __expf(a0.x - Mend); wkv[1] = __expf(a0.y - Mend); wkv[2] = __expf(a0.z - Mend); wkv[3] = __expf(a0.w - Mend);
                wkv[4] = __expf(a1.x - Mend); wkv[5] = __expf(a1.y - Mend); wkv[6] = __expf(a1.z - Mend); wkv[7] = __expf(a1.w - Mend); }
#pragma unroll
            for (int part = 0; part < 2; ++part) {
                const int col = part * 1024 + head * 256 + cq * 8;
                float wt[4][8], bb[8];
#pragma unroll
                for (int j = 0; j < 4; ++j) { const f32x4 w0 = *(const f32x4*)(convw + j * 2048 + col), w1 = *(const f32x4*)(convw + j * 2048 + col + 4);
                    wt[j][0] = w0.x; wt[j][1] = w0.y; wt[j][2] = w0.z; wt[j][3] = w0.w; wt[j][4] = w1.x; wt[j][5] = w1.y; wt[j][6] = w1.z; wt[j][7] = w1.w; }
                { const f32x4 b0 = *(const f32x4*)(convb + col), b1 = *(const f32x4*)(convb + col + 4); bb[0] = b0.x; bb[1] = b0.y; bb[2] = b0.z; bb[3] = b0.w; bb[4] = b1.x; bb[5] = b1.y; bb[6] = b1.z; bb[7] = b1.w; }
                v4u xr[11];
#pragma unroll
                for (int r = 0; r < 11; ++r) { const int tt = t0 - 3 + r; xr[r] = tt >= 0 ? *(const v4u*)(proj + (size_t)tt * NP + col) : (v4u){0u, 0u, 0u, 0u}; }
                const float sc = part == 0 ? 0.0625f : 1.0f;
#pragma unroll
                for (int tk = 0; tk < 8; ++tk) {
                    float acc[8];
#pragma unroll
                    for (int e = 0; e < 8; ++e) acc[e] = bb[e];
#pragma unroll
                    for (int j = 0; j < 4; ++j) { const v4u xv = xr[tk + j];
                        acc[0] += wt[j][0] * bf_lo(xv.x); acc[1] += wt[j][1] * bf_hi(xv.x); acc[2] += wt[j][2] * bf_lo(xv.y); acc[3] += wt[j][3] * bf_hi(xv.y);
                        acc[4] += wt[j][4] * bf_lo(xv.z); acc[5] += wt[j][5] * bf_hi(xv.z); acc[6] += wt[j][6] * bf_lo(xv.w); acc[7] += wt[j][7] * bf_hi(xv.w); }
#pragma unroll
                    for (int e = 0; e < 8; ++e) acc[e] = fast_silu(acc[e]) * sc;
                    v4u o; o.x = cvt_pk_bf16(acc[0], acc[1]); o.y = cvt_pk_bf16(acc[2], acc[3]); o.z = cvt_pk_bf16(acc[4], acc[5]); o.w = cvt_pk_bf16(acc[6], acc[7]);
                    *(v4u*)(QA + (size_t)(t0 + tk) * D + col) = o;
                    if (part == 1) { const float wk = wkv[tk]; LAS unsigned* kd = (LAS unsigned*)(KW + (tg * 8 + tk) * P5_KP + cq * 8);
                        kd[0] = cvt_pk_bf16(acc[0] * wk, acc[1] * wk); kd[1] = cvt_pk_bf16(acc[2] * wk, acc[3] * wk); kd[2] = cvt_pk_bf16(acc[4] * wk, acc[5] * wk); kd[3] = cvt_pk_bf16(acc[6] * wk, acc[7] * wk); }
                }
            }
        } else {
#pragma unroll 1
        for (int sub = 0; sub < 2; ++sub) {
            const int lrow = sub * 64 + tl, tok = c * 128 + lrow;
            {
                const int head = mh - 4, d0 = cb * 16;
                const float posf = (float)positions[tok];
                const float lg = logf(1.0f - exp2f(-5.0f - (float)head));
                const float gwt = __expf(lg * (float)(127 - (tok & 127)));
                float cs[16], sn[16];
#pragma unroll
                for (int e = 0; e < 16; ++e) {
                    const float inv = invf[e];
                    const float p = posf * inv, perr = fmaf(posf, inv, -p);
                    const float k = rintf(p * 0.15915494309189535f);
                    float r = fmaf(-k, 6.28125f, p); r += perr; r = fmaf(-k, 0.0019353071795864769f, r);
                    const float rev = r * 0.15915494309189535f;
                    cs[e] = __builtin_amdgcn_cosf(rev); sn[e] = __builtin_amdgcn_sinf(rev);
                }
#pragma unroll
                for (int part = 0; part < 2; ++part) {
                    const int pcol = 2048 + part * 1024 + head * 256 + d0, qcol = 2048 + part * 1024 + head * 256 + d0;
                    const v4u a0 = *(const v4u*)(proj + (size_t)tok * NP + pcol), a1 = *(const v4u*)(proj + (size_t)tok * NP + pcol + 8);
                    const v4u b0 = *(const v4u*)(proj + (size_t)tok * NP + pcol + 128), b1 = *(const v4u*)(proj + (size_t)tok * NP + pcol + 136);
                    float x1[16], x2[16];
                    x1[0] = bf_lo(a0.x); x1[1] = bf_hi(a0.x); x1[2] = bf_lo(a0.y); x1[3] = bf_hi(a0.y); x1[4] = bf_lo(a0.z); x1[5] = bf_hi(a0.z); x1[6] = bf_lo(a0.w); x1[7] = bf_hi(a0.w);
                    x1[8] = bf_lo(a1.x); x1[9] = bf_hi(a1.x); x1[10] = bf_lo(a1.y); x1[11] = bf_hi(a1.y); x1[12] = bf_lo(a1.z); x1[13] = bf_hi(a1.z); x1[14] = bf_lo(a1.w); x1[15] = bf_hi(a1.w);
                    x2[0] = bf_lo(b0.x); x2[1] = bf_hi(b0.x); x2[2] = bf_lo(b0.y); x2[3] = bf_hi(b0.y); x2[4] = bf_lo(b0.z); x2[5] = bf_hi(b0.z); x2[6] = bf_lo(b0.w); x2[7] = bf_hi(b0.w);
                    x2[8] = bf_lo(b1.x); x2[9] = bf_hi(b1.x); x2[10] = bf_lo(b1.y); x2[11] = bf_hi(b1.y); x2[12] = bf_lo(b1.z); x2[13] = bf_hi(b1.z); x2[14] = bf_lo(b1.w); x2[15] = bf_hi(b1.w);
                    const float sc = part == 1 ? 0.0625f : 1.0f;
                    float o1[16], o2[16];
#pragma unroll
                    for (int e = 0; e < 16; ++e) { o1[e] = (x1[e] * cs[e] - x2[e] * sn[e]) * sc; o2[e] = (x2[e] * cs[e] + x1[e] * sn[e]) * sc; }
#pragma unroll
                    for (int e8 = 0; e8 < 2; ++e8) {
                        v4u o; o.x = cvt_pk_bf16(o1[8 * e8], o1[8 * e8 + 1]); o.y = cvt_pk_bf16(o1[8 * e8 + 2], o1[8 * e8 + 3]); o.z = cvt_pk_bf16(o1[8 * e8 + 4], o1[8 * e8 + 5]); o.w = cvt_pk_bf16(o1[8 * e8 + 6], o1[8 * e8 + 7]);
                        *(v4u*)(QA + (size_t)tok * D + qcol + 8 * e8) = o;
                        v4u p; p.x = cvt_pk_bf16(o2[8 * e8], o2[8 * e8 + 1]); p.y = cvt_pk_bf16(o2[8 * e8 + 2], o2[8 * e8 + 3]); p.z = cvt_pk_bf16(o2[8 * e8 + 4], o2[8 * e8 + 5]); p.w = cvt_pk_bf16(o2[8 * e8 + 6], o2[8 * e8 + 7]);
                        *(v4u*)(QA + (size_t)tok * D + qcol + 128 + 8 * e8) = p; }
                    if (part == 1) {
#pragma unroll
                        for (int e = 0; e < 16; e += 2) {
                            *(LAS unsigned*)(KW + lrow * P5_KP + d0 + e) = cvt_pk_bf16(o1[e] * gwt, o1[e + 1] * gwt);
                            *(LAS unsigned*)(KW + lrow * P5_KP + 128 + d0 + e) = cvt_pk_bf16(o2[e] * gwt, o2[e + 1] * gwt); }
                    }
                }
            }
        }
        }
        bf16x8 bfr[4][4];
        { const bf16* vt = VT + (size_t)(mh * 512 + 64 * F.wave + fr) * S + c * 128 + fq * 8;
#pragma unroll
            for (int i = 0; i < 4; ++i)
#pragma unroll
                for (int kk = 0; kk < 4; ++kk) bfr[i][kk] = *(const bf16x8*)(vt + (size_t)(i * 16) * S + 32 * kk); }
        LDS_WAIT(); __syncthreads();
        if (mh < 4 && tu < 256) {
            float rs = 0.f;
#pragma unroll 16
            for (int r = 0; r < 128; ++r) rs += bf2f(KW[r * P5_KP + tu]);
            ((float*)(F.ws + WS_NPREV))[(size_t)(mh * 64 + c) * 256 + tu] = rs;
        }
        bf16* up = U + ((size_t)(mh * 64 + c) * 512 + 64 * F.wave + fr) * 256 + 4 * fq;
#pragma unroll 1
        for (int qd = 0; qd < 4; ++qd) {
            f32x4 acc[4][4];
#pragma unroll
            for (int i = 0; i < 4; ++i)
#pragma unroll
                for (int nn = 0; nn < 4; ++nn) acc[i][nn] = (f32x4){0.f, 0.f, 0.f, 0.f};
#pragma unroll
            for (int nn = 0; nn < 4; ++nn) {
                const LAS bf16* kc = KW + (8 * fq) * P5_KP + 64 * qd + 16 * nn + fr;
#pragma unroll
                for (int kk = 0; kk < 4; ++kk) {
                    bf16x8 af;
#pragma unroll
                    for (int j = 0; j < 8; ++j) af[j] = (short)kc[(32 * kk + j) * P5_KP];
#pragma unroll
                    for (int i = 0; i < 4; ++i) acc[i][nn] = __builtin_amdgcn_mfma_f32_16x16x32_bf16(af, bfr[i][kk], acc[i][nn], 0, 0, 0);
                }
            }
#pragma unroll
            for (int i = 0; i < 4; ++i)
#pragma unroll
                for (int nn = 0; nn < 4; ++nn) { const f32x4 v = acc[i][nn]; v2u o; o.x = cvt_pk_bf16(v[0], v[1]); o.y = cvt_pk_bf16(v[2], v[3]);
                    *(v2u*)(up + (size_t)(i * 16) * 256 + 64 * qd + 16 * nn) = o; }
        }
        __syncthreads();
    }
}

__device__ __forceinline__ float chunk_decay(Frame& F, int mh, int c) {
    if (mh < 4) { const float* MArr = (const float*)(F.ws + WS_MARR) + mh * S; const float mp = c > 0 ? MArr[c * 128 - 1] : 0.f; return __expf(mp - MArr[c * 128 + 127]); }
    return __expf(128.0f * logf(1.0f - exp2f(-5.0f - (float)(mh - 4))));
}
__device__ __forceinline__ void p7_scan(Frame& F) {
    int tz_ = threadIdx.x; asm volatile("" : "+v"(tz_)); const int tid_ = tz_, lane_ = tz_ & 63;
    bf16* U = (bf16*)(F.ws + WS_U);
    const int gid = (F.vcu * NWAVES + F.wave) * 64 + lane_, NT = F.G * NWAVES * 64;
    for (int e = gid; e < 8 * 16384; e += NT) {
        const int mh = e >> 14, rest = e & 16383;
        bf16* p = U + (size_t)(mh * 64) * 131072 + (size_t)rest * 8;
        float st[8];
#pragma unroll
        for (int q = 0; q < 8; ++q) st[q] = 0.f;
#pragma unroll 4
        for (int c = 0; c < 64; ++c) {
            const v4u u = *(const v4u*)(p + (size_t)c * 131072);
            v4u o; o.x = cvt_pk_bf16(st[0], st[1]); o.y = cvt_pk_bf16(st[2], st[3]); o.z = cvt_pk_bf16(st[4], st[5]); o.w = cvt_pk_bf16(st[6], st[7]);
            *(v4u*)(p + (size_t)c * 131072) = o;
            const float d = chunk_decay(F, mh, c);
            st[0] = d * st[0] + bf_lo(u.x); st[1] = d * st[1] + bf_hi(u.x); st[2] = d * st[2] + bf_lo(u.y); st[3] = d * st[3] + bf_hi(u.y);
            st[4] = d * st[4] + bf_lo(u.z); st[5] = d * st[5] + bf_hi(u.z); st[6] = d * st[6] + bf_lo(u.w); st[7] = d * st[7] + bf_hi(u.w);
        }
    }
    if (gid < 1024) {
        const int head = gid >> 8, dk = gid & 255; float sn = 0.f;
        float* np = (float*)(F.ws + WS_NPREV) + (size_t)(head * 64) * 256 + dk;
        for (int c = 0; c < 64; ++c) { const float rs = np[c * 256]; np[c * 256] = sn; sn = chunk_decay(F, head, c) * sn + rs; }
    }
}

constexpr int P8_KP = 264, P8_VP = 136;
constexpr int P8_KS_OFF = 0, P8_PB_OFF = 128 * P8_KP * 2, P8_PB_BYTES = 64 * P8_KP * 2;
static_assert(P8_PB_OFF + 2 * P8_PB_BYTES <= MISC_OFF, "P8 LDS map");
__device__ __forceinline__ void p8_outputs(Frame& F, const Args& a) {
    int tz_ = threadIdx.x; asm volatile("" : "+v"(tz_)); const int tid_ = tz_, lane_ = tz_ & 63;
    const bf16* QA = (const bf16*)(F.ws + WS_QA); const bf16* VT = (const bf16*)(F.ws + WS_VT); const bf16* U = (const bf16*)(F.ws + WS_U); const bf16* proj = (const bf16*)(F.ws + WS_R1);
    const int slab = F.wave;
    LAS unsigned char* KS = F.lds + P8_KS_OFF;
    for (int unit = F.vcu; unit < 512; unit += F.G) {
        int tu = tid_; asm volatile("" : "+v"(tu)); const int fr = tu & 15, fq = (tu & 63) >> 4;
        const int mh = unit >> 6, c = unit & 63, mixer = mh >> 2, head = mh & 3;
        const int j0 = slab * 16 + fr, tok = c * 128 + j0;
        const bf16* ctg = U + (size_t)(mh * 64 + c) * 131072;
        const bf16* vtg = VT + (size_t)(mh * 512) * S + c * 128;
        const int p_first = c > 0 ? 0 : 8;
        {
            const bf16* kg = QA + (size_t)(c * 128) * D + (mixer ? 3072 : 1024) + head * 256;
            v4u kr[8];
#pragma unroll
            for (int i = 0; i < 8; ++i) { const int idx = tu + 512 * i; kr[i] = *(const v4u*)(kg + (size_t)(idx >> 5) * D + (idx & 31) * 8); }
            v4u pr[4];
            if (c > 0) {
#pragma unroll
                for (int i = 0; i < 4; ++i) { const int idx = tu + 512 * i; pr[i] = *(const v4u*)(ctg + (size_t)(idx >> 5) * 256 + (idx & 31) * 8); }
            } else {
#pragma unroll
                for (int i = 0; i < 2; ++i) { const int idx = tu + 512 * i; pr[i] = *(const v4u*)(vtg + (size_t)(idx >> 4) * S + (idx & 15) * 8); }
            }
#pragma unroll
            for (int i = 0; i < 8; ++i) { const int idx = tu + 512 * i; *(LAS v4u*)(KS + (idx >> 5) * (P8_KP * 2) + (idx & 31) * 16) = kr[i]; }
            LAS unsigned char* pb = F.lds + P8_PB_OFF;
            if (c > 0) {
#pragma unroll
                for (int i = 0; i < 4; ++i) { const int idx = tu + 512 * i; *(LAS v4u*)(pb + (idx >> 5) * (P8_KP * 2) + (idx & 31) * 16) = pr[i]; }
            } else {
#pragma unroll
                for (int i = 0; i < 2; ++i) { const int idx = tu + 512 * i; *(LAS v4u*)(pb + (idx >> 4) * (P8_VP * 2) + (idx & 15) * 16) = pr[i]; }
            }
        }
        bf16x8 qf[8];
        { const bf16* qrow = QA + (size_t)tok * D + (mixer ? 2048 : 0) + head * 256 + fq * 8;
#pragma unroll
            for (int kk = 0; kk < 8; ++kk) qf[kk] = *(const bf16x8*)(qrow + 32 * kk); }
        LDS_WAIT(); __syncthreads();
        f32x4 sacc[8];
#pragma unroll
        for (int sb = 0; sb < 8; ++sb) sacc[sb] = (f32x4){0.f, 0.f, 0.f, 0.f};
        { const LAS unsigned char* kb = KS + fr * (P8_KP * 2) + fq * 16;
#pragma unroll
            for (int sb = 0; sb < 8; ++sb) if (sb <= slab) {
                bf16x8 af[8];
#pragma unroll
                for (int kk = 0; kk < 8; ++kk) af[kk] = *(const LAS bf16x8*)(kb + (16 * sb) * (P8_KP * 2) + 64 * kk);
#pragma unroll
                for (int kk = 0; kk < 8; ++kk) sacc[sb] = __builtin_amdgcn_mfma_f32_16x16x32_bf16(af[kk], qf[kk], sacc[sb], 0, 0, 0);
            } }
        float winter, psum = 0.f, Mt = 0.f;
        if (mixer == 0) {
            const float* aArr = (const float*)(F.ws + WS_AARR) + head * S + c * 128; const float* MArr = (const float*)(F.ws + WS_MARR) + head * S;
            Mt = MArr[tok]; const float mp = c > 0 ? MArr[c * 128 - 1] : 0.f; winter = __expf(mp - Mt);
#pragma unroll
            for (int sb = 0; sb < 8; ++sb) { const f32x4 av = *(const f32x4*)(aArr + 16 * sb + 4 * fq);
#pragma unroll
                for (int j = 0; j < 4; ++j) { const int kp = 16 * sb + 4 * fq + j; const float w = kp <= j0 ? __expf(fminf(av[j] - Mt, 0.f)) : 0.f; sacc[sb][j] *= w; psum += sacc[sb][j]; } }
        } else {
            const float lg = logf(1.0f - exp2f(-5.0f - (float)head));
            winter = __expf(lg * (float)(j0 + 1));
#pragma unroll
            for (int sb = 0; sb < 8; ++sb)
#pragma unroll
                for (int j = 0; j < 4; ++j) { const int kp = 16 * sb + 4 * fq + j; const float w = kp <= j0 ? __expf(lg * (float)(j0 - kp)) : 0.f; sacc[sb][j] *= w; }
        }
        bf16x8 pf[4];
#pragma unroll
        for (int ks = 0; ks < 4; ++ks) { v4u w; w.x = cvt_pk_bf16(sacc[2 * ks][0], sacc[2 * ks][1]); w.y = cvt_pk_bf16(sacc[2 * ks][2], sacc[2 * ks][3]);
            w.z = cvt_pk_bf16(sacc[2 * ks + 1][0], sacc[2 * ks + 1][1]); w.w = cvt_pk_bf16(sacc[2 * ks + 1][2], sacc[2 * ks + 1][3]); pf[ks] = __builtin_bit_cast(bf16x8, w); }
        float qn = 0.f;
        if (mixer == 0) {
            if (c > 0) { const float* np = (const float*)(F.ws + WS_NPREV) + (size_t)(head * 64 + c) * 256 + 8 * fq;
#pragma unroll
                for (int kk = 0; kk < 8; ++kk) { const f32x4 n0 = *(const f32x4*)(np + 32 * kk), n1 = *(const f32x4*)(np + 32 * kk + 4); const v4u qw = __builtin_bit_cast(v4u, qf[kk]);
                    qn += (bf_lo(qw.x) * n0.x + bf_hi(qw.x) * n0.y) + (bf_lo(qw.y) * n0.z + bf_hi(qw.y) * n0.w) + (bf_lo(qw.z) * n1.x + bf_hi(qw.z) * n1.y) + (bf_lo(qw.w) * n1.z + bf_hi(qw.w) * n1.w); } }
        }
        f32x4 acc[32];
#pragma unroll
        for (int n = 0; n < 32; ++n) acc[n] = (f32x4){0.f, 0.f, 0.f, 0.f};
#pragma unroll
        for (int p = 0; p < 16; ++p) {
            if (p >= p_first) {
                int tp = tid_; asm volatile("" : "+v"(tp));
                const int tfr = tp & 15, tfq = (tp & 63) >> 4;
                v4u pr[4];
                if (p + 1 < 8) {
#pragma unroll
                    for (int i = 0; i < 4; ++i) { const int idx = tp + 512 * i; pr[i] = *(const v4u*)(ctg + (size_t)(64 * (p + 1) + (idx >> 5)) * 256 + (idx & 31) * 8); }
                } else if (p + 1 < 16) {
#pragma unroll
                    for (int i = 0; i < 2; ++i) { const int idx = tp + 512 * i; pr[i] = *(const v4u*)(vtg + (size_t)(64 * (p + 1 - 8) + (idx >> 4)) * S + (idx & 15) * 8); }
                }
                const LAS unsigned char* pb = F.lds + P8_PB_OFF + (p & 1) * P8_PB_BYTES;
                if (p < 8) {
                    const LAS unsigned char* cb = pb + tfr * (P8_KP * 2) + tfq * 16;
#pragma unroll
                    for (int nn = 0; nn < 4; ++nn) {
                        bf16x8 af[8];
#pragma unroll
                        for (int kk = 0; kk < 8; ++kk) af[kk] = *(const LAS bf16x8*)(cb + (16 * nn) * (P8_KP * 2) + 64 * kk);
#pragma unroll
                        for (int kk = 0; kk < 8; ++kk) acc[4 * p + nn] = __builtin_amdgcn_mfma_f32_16x16x32_bf16(af[kk], qf[kk], acc[4 * p + nn], 0, 0, 0);
                    }
                } else {
                    if (p == 8) {
#pragma unroll
                        for (int n = 0; n < 32; ++n) acc[n] = acc[n] * winter;
                    }
                    const LAS unsigned char* vb = pb + tfr * (P8_VP * 2) + tfq * 8;
#pragma unroll
                    for (int nn = 0; nn < 4; ++nn) {
#pragma unroll
                        for (int ks = 0; ks < 4; ++ks) if (2 * ks <= slab) {
                            const v2u lo = *(const LAS v2u*)(vb + (16 * nn) * (P8_VP * 2) + 64 * ks), hi = *(const LAS v2u*)(vb + (16 * nn) * (P8_VP * 2) + 64 * ks + 32);
                            v4u w; w.x = lo.x; w.y = lo.y; w.z = hi.x; w.w = hi.y;
                            acc[4 * (p - 8) + nn] = __builtin_amdgcn_mfma_f32_16x16x32_bf16(__builtin_bit_cast(bf16x8, w), pf[ks], acc[4 * (p - 8) + nn], 0, 0, 0);
                        }
                    }
                }
                if (p + 1 < 16) {
                    LAS unsigned char* nb = F.lds + P8_PB_OFF + ((p + 1) & 1) * P8_PB_BYTES;
                    if (p + 1 < 8) {
#pragma unroll
                        for (int i = 0; i < 4; ++i) { const int idx = tp + 512 * i; *(LAS v4u*)(nb + (idx >> 5) * (P8_KP * 2) + (idx & 31) * 16) = pr[i]; }
                    } else {
#pragma unroll
                        for (int i = 0; i < 2; ++i) { const int idx = tp + 512 * i; *(LAS v4u*)(nb + (idx >> 4) * (P8_VP * 2) + (idx & 15) * 16) = pr[i]; }
                    }
                    LDS_WAIT(); __syncthreads();
                }
            }
        }
        if (mixer == 0) {
            qn += __shfl_xor(qn, 16); qn += __shfl_xor(qn, 32);
            psum += __shfl_xor(psum, 16); psum += __shfl_xor(psum, 32);
            const float den = psum + winter * qn;
            const float Bm = ((const float*)(F.ws + WS_BMARR))[head * S + tok];
            const float inv = 1.0f / fmaxf(fabsf(den), __expf(-Bm));
#pragma unroll
            for (int n = 0; n < 32; ++n) acc[n] = acc[n] * inv;
        }
        float s1 = 0.f;
#pragma unroll
        for (int n = 0; n < 32; ++n) s1 += (acc[n][0] + acc[n][1]) + (acc[n][2] + acc[n][3]);
        s1 += __shfl_xor(s1, 16); s1 += __shfl_xor(s1, 32);
        const float mean = s1 * (1.0f / 512.0f); float s2 = 0.f;
#pragma unroll
        for (int n = 0; n < 32; ++n) { acc[n] = acc[n] - mean; s2 += (acc[n][0] * acc[n][0] + acc[n][1] * acc[n][1]) + (acc[n][2] * acc[n][2] + acc[n][3] * acc[n][3]); }
        s2 += __shfl_xor(s2, 16); s2 += __shfl_xor(s2, 32);
        const float rstd = 1.0f / sqrtf(s2 * (1.0f / 512.0f) + HEAD_EPS);
        int te = tid_; asm volatile("" : "+v"(te)); const int efq = (te & 63) >> 4, etok = c * 128 + slab * 16 + (te & 15);
        const float* gain = (const float*)a.in[mixer ? 12 : 11] + head * 512 + 4 * efq;
        const bf16* gp = proj + (size_t)etok * NP + (mixer ? 4096 : 6144) + head * 512 + 4 * efq;
        bf16* yp = (bf16*)(F.ws + WS_Y) + (size_t)etok * D + mixer * 2048 + head * 512 + 4 * efq;
#pragma unroll
        for (int n = 0; n < 32; ++n) {
            const f32x4 gn = *(const f32x4*)(gain + 16 * n); const v2u gw2 = *(const v2u*)(gp + 16 * n);
            const float g0 = bf_lo(gw2.x), g1 = bf_hi(gw2.x), g2 = bf_lo(gw2.y), g3 = bf_hi(gw2.y);
            float y0 = acc[n][0] * rstd * gn.x, y1 = acc[n][1] * rstd * gn.y, y2 = acc[n][2] * rstd * gn.z, y3 = acc[n][3] * rstd * gn.w;
            if (mixer == 0) { y0 *= fast_sigmoid(g0); y1 *= fast_sigmoid(g1); y2 *= fast_sigmoid(g2); y3 *= fast_sigmoid(g3); }
            else { y0 *= fast_silu(g0); y1 *= fast_silu(g1); y2 *= fast_silu(g2); y3 *= fast_silu(g3); }
            v2u o; o.x = cvt_pk_bf16(y0, y1); o.y = cvt_pk_bf16(y2, y3);
            *(v2u*)(yp + 16 * n) = o;
        }
        __syncthreads();
    }
}

__global__ void __launch_bounds__(NWAVES * 64, 2) fwd_kernel(Args args) {
    extern __shared__ __attribute__((aligned(16))) unsigned char lds_raw[];
    Frame F;
    F.lds = (LAS unsigned char*)lds_raw; F.ws = args.ws; F.in = nullptr;
    F.tid = threadIdx.x; F.lane = F.tid & 63; F.wave = __builtin_amdgcn_readfirstlane(F.tid >> 6);
    F.G = gridDim.x; { const int bx = blockIdx.x; F.vcu = (F.G % 8 == 0) ? (bx % 8) * (F.G / 8) + bx / 8 : bx; }
    volatile LAS unsigned* MISC = (volatile LAS unsigned*)(F.lds + MISC_OFF);
    for (int u = F.tid; u < 128; u += NWAVES * 64) MISC[u] = 0u;
    __syncthreads();
    const int lo = args.ph_lo, hi = args.ph_hi;
    XcdBarrier bar; bar.bar = (unsigned*)(F.ws + WS_CTL) + CW_BAR; bar.x = 0; bar.st = nullptr;
    if (hi - lo > 1) bar = xcd_barrier_post((unsigned*)(F.ws + WS_CTL) + CW_BAR, MISC + 8);
#ifndef PH_MASK
#define PH_MASK 0xFFFF
#endif
#define IN(k) (((PH_MASK >> (k)) & 1) && lo <= (k) && (k) < hi)
#define SEAM(k) do { if (IN(k) && IN((k) + 1)) xcd_barrier(bar); } while (0)
    LAS unsigned char* ring = F.lds;
    bf16* const XB = (bf16*)(F.ws + WS_XB); bf16* const R1 = (bf16*)(F.ws + WS_R1); float* const T = (float*)(F.ws + WS_T);
    float* const HF = (float*)(F.ws + WS_HF); bf16* const HB = (bf16*)(F.ws + WS_HB);

#ifndef REP_MASK
#define REP_MASK 0
#endif
#define PHASE(k, ...) do { if (IN(k)) { __VA_ARGS__ if ((REP_MASK >> (k)) & 1) { xcd_barrier(bar); __VA_ARGS__ } } SEAM(k); } while (0)
    PHASE(0, { p0_convert(F, args); });
    PHASE(1, { pg8::Gemm g{XB, (const bf16*)(F.ws + WS_WGU1), S, 2 * FF, D}; pg8::StaticOrder so; so.init(S, 2 * FF, F.G, (int)blockIdx.x);
        pg8::EpiSwiGLU E{R1, FF}; pg8::gemm_phase<pg8::EpiSwiGLU, pg8::StaticOrder, true, true>(ring, g, so, E);
        if (F.G == 256 && (int)blockIdx.x >= 192) p0_tiles(F, args, T_WD1_LO, T_WD1_HI, ((int)blockIdx.x - 192) * NWAVES + F.wave, 64 * NWAVES); });
    PHASE(2, { pg8::Gemm g{R1, (const bf16*)(F.ws + WS_WD1), S, D, FF}; pg8::StaticOrder so; so.init(S, D, F.G, (int)blockIdx.x);
        pg8::EpiResid E{(const float*)args.in[0], T, D, ALPHA, 0.5f, (float*)(F.ws + WS_PART)}; pg8::gemm_phase<pg8::EpiResid, pg8::StaticOrder, true, true>(ring, g, so, E); });
    PHASE(3, { ln_phase<1>(F, T, (const float*)args.in[5], (const float*)args.in[6], nullptr, HB, (const float*)args.in[8]); });
    PHASE(4, {
        if (blockIdx.x < 4) gate_scan(F, (int)blockIdx.x);
        { pg8::Gemm g{HB, (const bf16*)(F.ws + WS_WIN), S, 6144, D}; pg8::StaticOrder so; so.init(S, 6144, F.G, (int)blockIdx.x);
          pg8::EpiPlainBf16 E{R1, NP}; pg8::gemm_phase<pg8::EpiPlainBf16, pg8::StaticOrder, true, true>(ring, g, so, E); }
        { pg8::Gemm g{(const bf16*)(F.ws + WS_H8), (const bf16*)(F.ws + WS_W8), S, 10240, D / 2}; pg8::StaticOrder so; so.init(S, 10240, F.G, (int)blockIdx.x);
          pg8::EpiPlainBf16 E{R1 + 6144, NP}; pg8::gemm_phase<pg8::EpiPlainBf16, pg8::StaticOrder, true, true, false, true>(ring, g, so, E); }
        { pg8::Gemm g{(const bf16*)(F.ws + WS_WIN) + (size_t)NP * D, HB, 4096, S, D}; pg8::StaticOrder so; so.init(4096, S, F.G, (int)blockIdx.x);
          pg8::EpiPlainBf16 E{(bf16*)(F.ws + WS_VT), S}; pg8::gemm_phase<pg8::EpiPlainBf16, pg8::StaticOrder, true, true>(ring, g, so, E); }
    });
    PHASE(5, { p5_states(F, args); });
    if (IN(6)) { p7_scan(F); } SEAM(6);
    PHASE(7, { p8_outputs(F, args); });
    PHASE(8, { pg8::Gemm g{(const bf16*)(F.ws + WS_Y), (const bf16*)(F.ws + WS_WPM), S, D, D}; pg8::StaticOrder so; so.init(S, D, F.G, (int)blockIdx.x);
        pg8::EpiMerged E{(bf16*)(F.ws + WS_MRG), R1 + 8192, R1 + 12288, NP, D}; pg8::gemm_phase<pg8::EpiMerged, pg8::StaticOrder, true, true, true>(ring, g, so, E); });
    PHASE(9, { pg8::Gemm g{(const bf16*)(F.ws + WS_MRG), (const bf16*)(F.ws + WS_WO), S, D, D}; pg8::StaticOrder so; so.init(S, D, F.G, (int)blockIdx.x);
        typedef pg8::EpiResidLN<WS_T, WS_HF, WS_STATS, WS_PART> EpiA; EpiA E{F.ws, (const float*)args.in[5], (const float*)args.in[6], 1.0f}; pg8::gemm_phase<EpiA, pg8::StaticOrder, true, true>(ring, g, so, E); });
    PHASE(10, { ln_phase<2>(F, HF, (const float*)args.in[16], (const float*)args.in[17], nullptr, HB, nullptr); });
    PHASE(11, { pg8::Gemm g{HB, (const bf16*)(F.ws + WS_WGU2), S, 2 * FF, D}; pg8::StaticOrder so; so.init(S, 2 * FF, F.G, (int)blockIdx.x);
        pg8::EpiSwiGLU E{R1, FF}; pg8::gemm_phase<pg8::EpiSwiGLU, pg8::StaticOrder, true, true>(ring, g, so, E);
        if (F.G == 256 && (int)blockIdx.x >= 192) p0_tiles(F, args, T_LATE, N_TILES, ((int)blockIdx.x - 192) * NWAVES + F.wave, 64 * NWAVES); });
    PHASE(12, { pg8::Gemm g{R1, (const bf16*)(F.ws + WS_WD2), S, D, FF}; pg8::StaticOrder so; so.init(S, D, F.G, (int)blockIdx.x);
        typedef pg8::EpiResidLN<WS_HF, WS_T, WS_STATS, WS_PART> EpiB; EpiB E{F.ws, (const float*)args.in[16], (const float*)args.in[17], 0.5f}; pg8::gemm_phase<EpiB, pg8::StaticOrder, true, true>(ring, g, so, E); });
    PHASE(13, { ln_phase<3>(F, T, (const float*)args.in[21], (const float*)args.in[22], args.out, nullptr, nullptr); });
#undef PHASE
#ifdef DBG_STOP
    if (lo == 100) {
        const size_t gt = (size_t)blockIdx.x * 512 + threadIdx.x, NT = (size_t)gridDim.x * 512;
        if (DBG_BF16) { const bf16* src = (const bf16*)(F.ws + (size_t)DBG_OFF_MIB * MiB); for (size_t i = gt; i < (size_t)S * D; i += NT) args.out[i] = i < (size_t)DBG_N ? bf2f(src[i]) : 0.f; }
        else { const float* src = (const float*)(F.ws + (size_t)DBG_OFF_MIB * MiB); for (size_t i = gt; i < (size_t)S * D; i += NT) args.out[i] = src[i]; }
    }
#endif
#undef IN
#undef SEAM
}

extern "C" void kernel_launch(void* const* d_in, const int* in_sizes, int n_in, void* d_out, int out_size, void* d_ws, size_t ws_size, hipStream_t stream) {
    static int grid = 0;
    if (grid == 0) {
        if (n_in != 23 || out_size != S * D || ws_size < WS_END2) { fprintf(stderr, "kernel_launch: unexpected problem (n_in %d out %d ws %zu need %zu)\n", n_in, out_size, ws_size, (size_t)WS_END2); grid = -1; return; }
        int dev = 0, cus = 0, per_cu = 0;
        if (hipGetDevice(&dev) != hipSuccess || hipDeviceGetAttribute(&cus, hipDeviceAttributeMultiprocessorCount, dev) != hipSuccess) { grid = -1; return; }
        if (hipFuncSetAttribute((const void*)fwd_kernel, hipFuncAttributeMaxDynamicSharedMemorySize, LDS_BYTES) != hipSuccess) { fprintf(stderr, "kernel_launch: hipFuncSetAttribute failed\n"); grid = -1; return; }
        if (hipOccupancyMaxActiveBlocksPerMultiprocessor(&per_cu, (const void*)fwd_kernel, NWAVES * 64, LDS_BYTES) != hipSuccess || per_cu < 1) { fprintf(stderr, "kernel_launch: occupancy query says %d\n", per_cu); }
        (void)hipGetLastError();
        grid = cus;
    }
    if (grid < 0) return;
    (void)hipMemsetAsync((char*)d_ws + WS_CTL, 0, CTL_ZERO_BYTES, stream);
#ifdef DBG_NANFILL
    (void)hipMemsetAsync((char*)d_ws + CTL_ZERO_BYTES, 0xFF, WS_END2 - CTL_ZERO_BYTES, stream);
#endif
    Args a{};
    for (int i = 0; i < 23; ++i) a.in[i] = d_in[i];
    a.out = (float*)d_out; a.ws = (unsigned char*)d_ws;
#if MK_ONE_LAUNCH
    a.ph_lo = 0; a.ph_hi = NPH;
    hipLaunchKernelGGL(fwd_kernel, dim3(grid), dim3(NWAVES * 64), LDS_BYTES, stream, a);
#else
#ifdef DBG_STOP
    for (int p = 0; p <= DBG_STOP; ++p) { a.ph_lo = p; a.ph_hi = p + 1; hipLaunchKernelGGL(fwd_kernel, dim3(grid), dim3(NWAVES * 64), LDS_BYTES, stream, a); }
    a.ph_lo = 100; a.ph_hi = 101; hipLaunchKernelGGL(fwd_kernel, dim3(grid), dim3(NWAVES * 64), LDS_BYTES, stream, a);
#else
    for (int p = 0; p < NPH; ++p) { a.ph_lo = p; a.ph_hi = p + 1; hipLaunchKernelGGL(fwd_kernel, dim3(grid), dim3(NWAVES * 64), LDS_BYTES, stream, a); }
#endif
#endif
}
```
